# Optimizing an MI355X kernel written in HIP

```python
import math
import jax, jax.numpy as jnp
from jax import lax
import numpy as np

D_MODEL = 4096
BATCH = 2
SEQ = 8192
DEPTH = 1

MIX_WIDTH = D_MODEL
GROUP_WIDTH = MIX_WIDTH // 2
GLA_HEADS = 4
GLA_DV = GROUP_WIDTH // GLA_HEADS
GLA_DK = GLA_DV // 2
GLA_GATE_RANK = 16
GLA_TAU = 16.0
GLA_CHUNK = 64
MLSTM_HEADS = 4
MLSTM_DV = GROUP_WIDTH // MLSTM_HEADS
MLSTM_DK = MLSTM_DV // 2
MLSTM_CHUNK = 64
CONV_WIDTH = 4
MEM_TOKENS = 256
XATTN_HEADS = 4
XATTN_HEAD_DIM = D_MODEL // XATTN_HEADS
FFN_HIDDEN = 256 * math.ceil(8 * D_MODEL / (3 * 256))
EPS = 1e-6

SPLIT_SIZES = (
    GLA_HEADS * GLA_DK,
    GLA_HEADS * GLA_DK,
    GLA_HEADS * GLA_DV,
    GLA_HEADS * GLA_DV,
    GLA_GATE_RANK,
    MLSTM_HEADS * MLSTM_DK,
    MLSTM_HEADS * MLSTM_DK,
    MLSTM_HEADS * MLSTM_DV,
    MLSTM_HEADS * MLSTM_DV,
    MLSTM_HEADS,
    MLSTM_HEADS,
)
IN_COLS = sum(SPLIT_SIZES)

kernel_name = "hybrid_gla_mlstm_parallel_heads"


def rmsnorm(x, g):
    xf = x.astype(jnp.float32)
    y = xf * lax.rsqrt(jnp.mean(xf * xf, axis=-1, keepdims=True) + EPS)
    return (y * g.astype(jnp.float32)).astype(x.dtype)


def head_rmsnorm(h, g):
    y = h * lax.rsqrt(jnp.mean(h * h, axis=-1, keepdims=True) + EPS)
    return y * g.astype(jnp.float32)


def to_chunks(t, c):
    b, s, h = t.shape[:3]
    t = t.reshape((b, s // c, c, h) + t.shape[3:])
    return jnp.moveaxis(t, (1, 3), (0, 2))


def from_chunks(t):
    t = jnp.moveaxis(t, (0, 2), (1, 3))
    b, n, c, h, d = t.shape
    return t.reshape(b, n * c, h, d)


def gla_chunked(q, k, v, log_a):
    bsz = q.shape[0]
    qc, kc, vc = to_chunks(q, GLA_CHUNK), to_chunks(k, GLA_CHUNK), to_chunks(v, GLA_CHUNK)
    bc = lax.cumsum(to_chunks(log_a, GLA_CHUNK), axis=3)
    mask = jnp.tril(jnp.ones((GLA_CHUNK, GLA_CHUNK), dtype=bool))

    def body(state, inp):
        qb, kb, vb, bb = inp
        diff = jnp.where(mask[None, None, :, :, None],
                         bb[:, :, :, None, :] - bb[:, :, None, :, :], -jnp.inf)
        attn = jnp.sum(qb[:, :, :, None, :] * kb[:, :, None, :, :] * jnp.exp(diff), axis=-1)
        out = (jnp.einsum('bhts,bhsv->bhtv', attn, vb)
               + jnp.einsum('bhtd,bhdv->bhtv', qb * jnp.exp(bb), state))
        b_last = bb[:, :, -1:, :]
        state = (jnp.exp(b_last[:, :, 0, :, None]) * state
                 + jnp.einsum('bhsd,bhsv->bhdv', kb * jnp.exp(b_last - bb), vb))
        return state, out

    state0 = jnp.zeros((bsz, GLA_HEADS, GLA_DK, GLA_DV), jnp.float32)
    _, out = lax.scan(body, state0, (qc, kc, vc, bc))
    return from_chunks(out)


def mlstm_chunked(q, k, v, i_pre, log_f):
    bsz = q.shape[0]
    qc, kc, vc = to_chunks(q, MLSTM_CHUNK), to_chunks(k, MLSTM_CHUNK), to_chunks(v, MLSTM_CHUNK)
    ic = to_chunks(i_pre, MLSTM_CHUNK)
    bc = lax.cumsum(to_chunks(log_f, MLSTM_CHUNK), axis=3)
    mask = jnp.tril(jnp.ones((MLSTM_CHUNK, MLSTM_CHUNK), dtype=bool))

    def body(carry, inp):
        c_prev, n_prev, m_prev = carry
        qb, kb, vb, ib, bb = inp
        log_d = jnp.where(mask, bb[..., :, None] - bb[..., None, :] + ib[..., None, :], -jnp.inf)
        inter_log = bb + m_prev[..., None]
        m = jnp.maximum(inter_log, jnp.max(log_d, axis=-1))
        g_inter = jnp.exp(inter_log - m)
        scores = jnp.einsum('bhtd,bhsd->bhts', qb, kb) * jnp.exp(log_d - m[..., None])
        num = (jnp.einsum('bhts,bhsv->bhtv', scores, vb)
               + g_inter[..., None] * jnp.einsum('bhtd,bhdv->bhtv', qb, c_prev))
        den = jnp.sum(scores, axis=-1) + g_inter * jnp.einsum('bhtd,bhd->bht', qb, n_prev)
        h = num / jnp.maximum(jnp.abs(den), jnp.exp(-m))[..., None]
        b_last = bb[..., -1]
        log_w = b_last[..., None] - bb + ib
        m_new = jnp.maximum(b_last + m_prev, jnp.max(log_w, axis=-1))
        w = jnp.exp(log_w - m_new[..., None])
        decay = jnp.exp(b_last + m_prev - m_new)
        c_new = decay[..., None, None] * c_prev + jnp.einsum('bhs,bhsd,bhsv->bhdv', w, kb, vb)
        n_new = decay[..., None] * n_prev + jnp.einsum('bhs,bhsd->bhd', w, kb)
        return (c_new, n_new, m_new), h

    carry0 = (jnp.zeros((bsz, MLSTM_HEADS, MLSTM_DK, MLSTM_DV), jnp.float32),
              jnp.zeros((bsz, MLSTM_HEADS, MLSTM_DK), jnp.float32),
              jnp.zeros((bsz, MLSTM_HEADS), jnp.float32))
    _, out = lax.scan(body, carry0, (qc, kc, vc, ic, bc))
    return from_chunks(out)


def causal_dwconv(x, w, b):
    y = lax.conv_general_dilated(
        x, w[:, None, :].astype(x.dtype), window_strides=(1,),
        padding=[(CONV_WIDTH - 1, 0)], dimension_numbers=('NWC', 'WIO', 'NWC'),
        feature_group_count=x.shape[-1])
    return y + b.astype(x.dtype)


def hybrid_mixer(n, w_in, gla_gate_w2, gla_gate_b, gla_norm_g, mlstm_conv_w, mlstm_conv_b,
                 mlstm_igate_b, mlstm_fgate_b, mlstm_norm_g, w_out):
    bsz, s, _ = n.shape
    f32 = jnp.float32
    proj = n @ w_in
    offsets = np.cumsum(SPLIT_SIZES)[:-1].tolist()
    qg, kg, vg, gg, ag, qm, km, vm, om, im, fm = jnp.split(proj, offsets, axis=-1)

    qg = qg.astype(f32).reshape(bsz, s, GLA_HEADS, GLA_DK) * (GLA_DK ** -0.5)
    kg = kg.astype(f32).reshape(bsz, s, GLA_HEADS, GLA_DK)
    vg = vg.astype(f32).reshape(bsz, s, GLA_HEADS, GLA_DV)
    gate_logit = (ag @ gla_gate_w2 + gla_gate_b).astype(f32)
    log_a = (jax.nn.log_sigmoid(gate_logit) / GLA_TAU).reshape(bsz, s, GLA_HEADS, GLA_DK)
    o_gla = gla_chunked(qg, kg, vg, log_a)
    o_gla = head_rmsnorm(o_gla, gla_norm_g) * jax.nn.silu(
        gg.astype(f32)).reshape(bsz, s, GLA_HEADS, GLA_DV)
    o_gla = o_gla.reshape(bsz, s, GROUP_WIDTH)

    qk = jax.nn.silu(causal_dwconv(jnp.concatenate([qm, km], axis=-1), mlstm_conv_w, mlstm_conv_b))
    qm, km = jnp.split(qk.astype(f32), 2, axis=-1)
    qm = qm.reshape(bsz, s, MLSTM_HEADS, MLSTM_DK)
    km = km.reshape(bsz, s, MLSTM_HEADS, MLSTM_DK) * (MLSTM_DK ** -0.5)
    vm = vm.astype(f32).reshape(bsz, s, MLSTM_HEADS, MLSTM_DV)
    i_pre = (im + mlstm_igate_b).astype(f32)
    log_f = jax.nn.log_sigmoid((fm + mlstm_fgate_b).astype(f32))
    h = mlstm_chunked(qm, km, vm, i_pre, log_f)
    o_ml = jax.nn.sigmoid(om.astype(f32)).reshape(bsz, s, MLSTM_HEADS, MLSTM_DV) * head_rmsnorm(h, mlstm_norm_g)
    o_ml = o_ml.reshape(bsz, s, GROUP_WIDTH)

    mixed = jnp.concatenate([o_gla, o_ml], axis=-1).astype(n.dtype)
    return mixed @ w_out


def cross_attention(n, mem_n, wq, wk, wv, wo):
    bsz, s, _ = n.shape
    m = mem_n.shape[1]
    q = (n @ wq).reshape(bsz, s, XATTN_HEADS, XATTN_HEAD_DIM)
    k = (mem_n @ wk).reshape(bsz, m, XATTN_HEADS, XATTN_HEAD_DIM)
    v = (mem_n @ wv).reshape(bsz, m, XATTN_HEADS, XATTN_HEAD_DIM)
    scores = jnp.einsum('bshd,bmhd->bhsm', q, k).astype(jnp.float32) * (XATTN_HEAD_DIM ** -0.5)
    p = jax.nn.softmax(scores, axis=-1).astype(v.dtype)
    o = jnp.einsum('bhsm,bmhd->bshd', p, v).reshape(bsz, s, D_MODEL)
    return o @ wo


def swiglu(n, w_gate, w_up, w_down):
    return (jax.nn.silu(n @ w_gate) * (n @ w_up)) @ w_down


def setup_inputs(seed: int = 0) -> dict:
    key = jax.random.key(seed)
    ks = jax.random.split(key, 26)
    f32 = jnp.float32

    def dense(k, shape, fan_in):
        return jax.random.normal(k, shape, f32) * (fan_in ** -0.5)

    def gain(k, shape):
        return 1.0 + 0.01 * jax.random.normal(k, shape, f32)

    def small(k, shape):
        return 0.01 * jax.random.normal(k, shape, f32)

    L = DEPTH
    qk_ch = 2 * MLSTM_HEADS * MLSTM_DK
    return {
        "x": jax.random.normal(ks[0], (BATCH, SEQ, D_MODEL), f32),
        "mem": jax.random.normal(ks[1], (BATCH, MEM_TOKENS, D_MODEL), f32),
        "norm_mix_g": gain(ks[2], (L, D_MODEL)),
        "w_in": dense(ks[3], (L, D_MODEL, IN_COLS), D_MODEL),
        "gla_gate_w2": dense(ks[4], (L, GLA_GATE_RANK, GLA_HEADS * GLA_DK), GLA_GATE_RANK),
        "gla_gate_b": small(ks[5], (L, GLA_HEADS * GLA_DK)),
        "gla_norm_g": gain(ks[6], (L, GLA_HEADS, GLA_DV)),
        "mlstm_conv_w": dense(ks[7], (L, CONV_WIDTH, qk_ch), CONV_WIDTH),
        "mlstm_conv_b": small(ks[8], (L, qk_ch)),
        "mlstm_igate_b": small(ks[9], (L, MLSTM_HEADS)),
        "mlstm_fgate_b": jnp.linspace(3.0, 6.0, MLSTM_HEADS, dtype=f32)[None, :]
                          + 0.1 * jax.random.normal(ks[10], (L, MLSTM_HEADS), f32),
        "mlstm_norm_g": gain(ks[11], (L, MLSTM_HEADS, MLSTM_DV)),
        "w_out": dense(ks[12], (L, MIX_WIDTH, D_MODEL), MIX_WIDTH),
        "norm_cross_g": gain(ks[13], (L, D_MODEL)),
        "norm_mem_g": gain(ks[14], (L, D_MODEL)),
        "wq_c": dense(ks[15], (L, D_MODEL, D_MODEL), D_MODEL),
        "wk_c": dense(ks[16], (L, D_MODEL, D_MODEL), D_MODEL),
        "wv_c": dense(ks[17], (L, D_MODEL, D_MODEL), D_MODEL),
        "wo_c": dense(ks[18], (L, D_MODEL, D_MODEL), D_MODEL),
        "norm_ffn_g": gain(ks[19], (L, D_MODEL)),
        "w_gate": dense(ks[20], (L, D_MODEL, FFN_HIDDEN), D_MODEL),
        "w_up": dense(ks[21], (L, D_MODEL, FFN_HIDDEN), D_MODEL),
        "w_down": dense(ks[22], (L, FFN_HIDDEN, D_MODEL), FFN_HIDDEN),
        "norm_final_g": gain(ks[23], (D_MODEL,)),
    }


def reference(x, mem, norm_mix_g, w_in, gla_gate_w2, gla_gate_b, gla_norm_g, mlstm_conv_w,
              mlstm_conv_b, mlstm_igate_b, mlstm_fgate_b, mlstm_norm_g, w_out, norm_cross_g,
              norm_mem_g, wq_c, wk_c, wv_c, wo_c, norm_ffn_g, w_gate, w_up, w_down, norm_final_g):
    h = x
    for l in range(DEPTH):
        h = h + hybrid_mixer(rmsnorm(h, norm_mix_g[l]), w_in[l], gla_gate_w2[l], gla_gate_b[l],
                             gla_norm_g[l], mlstm_conv_w[l], mlstm_conv_b[l], mlstm_igate_b[l],
                             mlstm_fgate_b[l], mlstm_norm_g[l], w_out[l])
        h = h + cross_attention(rmsnorm(h, norm_cross_g[l]), rmsnorm(mem, norm_mem_g[l]),
                                wq_c[l], wk_c[l], wv_c[l], wo_c[l])
        h = h + swiglu(rmsnorm(h, norm_ffn_g[l]), w_gate[l], w_up[l], w_down[l])
    return rmsnorm(h, norm_final_g)
```

```cpp
#include <hip/hip_runtime.h>
#include <cstdio>
#include <cstdint>

#define LAS __attribute__((address_space(3)))
#define GAS __attribute__((address_space(1)))
typedef unsigned short bf16_t;
typedef short bf16x8 __attribute__((ext_vector_type(8)));
typedef float f32x4 __attribute__((ext_vector_type(4)));
typedef float f32x2 __attribute__((ext_vector_type(2)));
typedef float f32x16 __attribute__((ext_vector_type(16)));
typedef unsigned u32x4 __attribute__((ext_vector_type(4)));
typedef unsigned u32x2 __attribute__((ext_vector_type(2)));
typedef GAS unsigned gu32;
#define RLX_AGENT __ATOMIC_RELAXED, __HIP_MEMORY_SCOPE_AGENT
#define DI __device__ __forceinline__

constexpr int D = 4096, SEQ = 8192, M = 16384, NPROJ = 12288, INCOLS = 12312, FF = 11008, NCH = 128;
constexpr float EPS = 1e-6f;
constexpr int C_QG = 0, C_KG = 1024, C_VG = 2048, C_GG = 4096, C_QM = 6144, C_KM = 7168, C_VM = 8192, C_OM = 10240;

constexpr size_t MiB = 1u << 20;
constexpr size_t WS_CTL = 0, CTL_ZERO_BYTES = 1 * MiB;
constexpr size_t WS_RSTD0 = 1 * MiB;
constexpr size_t WS_SMALLP = 2 * MiB;
constexpr size_t WS_SS1 = 4 * MiB, WS_SS2 = 8 * MiB, WS_SS3 = 12 * MiB;
constexpr size_t WS_WSMALL = 16 * MiB;
constexpr size_t WS_MEMN = 17 * MiB;
constexpr size_t WS_KB = 24 * MiB, WS_VB = 28 * MiB;
constexpr size_t WS_WQK = 32 * MiB;
constexpr size_t WS_VW = 48 * MiB;
constexpr size_t WS_WOUT = 64 * MiB, WS_WQ = 96 * MiB, WS_WK = 128 * MiB, WS_WV = 160 * MiB, WS_WO = 192 * MiB;
constexpr size_t WS_WGU = 224 * MiB;
constexpr size_t WS_WDN = 396 * MiB;
constexpr size_t WS_WIN = 482 * MiB;
constexpr size_t WS_XB = 578 * MiB;
constexpr size_t WS_DEC = 482 * MiB;
constexpr size_t WS_MST = 483 * MiB;
constexpr size_t WS_KSUM = 484 * MiB;
constexpr size_t WS_NPREV = 485 * MiB;
constexpr size_t WS_DENAUX = 486 * MiB;
constexpr size_t WS_AQM = 490 * MiB, WS_AQG = 522 * MiB, WS_AKG = 554 * MiB, WS_AKM = 586 * MiB;
constexpr size_t WS_PMG = 618 * MiB, WS_PMM = 626 * MiB;
constexpr size_t WS_MIXED = 522 * MiB;
constexpr size_t WS_P = 650 * MiB;
constexpr size_t WS_PROJ = 706 * MiB;
constexpr size_t WS_ACT = 706 * MiB;
constexpr size_t WS_OUTG = 1090 * MiB, WS_OUTM = 1154 * MiB;
constexpr size_t WS_HB = 1090 * MiB;
constexpr size_t WS_END = 1218 * MiB;

constexpr int CW_TMO = 0, CW_CODE = 1, CW_BAR = 4096;

constexpr int RING_BYTES = 131072;
constexpr int LDS_X0 = RING_BYTES;
constexpr int LDS_X1 = RING_BYTES + 8192;
constexpr int LDSCTL_OFF = RING_BYTES + 12288, MISC_OFF = LDSCTL_OFF + 64;
constexpr int LDS_BYTES = 147456;
constexpr int NWAVES = 8;

DI unsigned f2bf(float f) { unsigned u = __builtin_bit_cast(unsigned, f); return (u + 0x7fffu + ((u >> 16) & 1u)) >> 16; }
DI unsigned pk2(float lo, float hi) { return f2bf(lo) | (f2bf(hi) << 16); }
DI float bf2f(unsigned short b) { return __builtin_bit_cast(float, ((unsigned)b) << 16); }
DI float bflo(unsigned w) { return __builtin_bit_cast(float, w << 16); }
DI float bfhi(unsigned w) { return __builtin_bit_cast(float, w & 0xffff0000u); }
DI unsigned cvt_pk_bf16(float lo, float hi) { unsigned r; asm volatile("v_cvt_pk_bf16_f32 %0, %1, %2" : "=v"(r) : "v"(lo), "v"(hi)); return r; }
DI float wave_sum(float v) {
#pragma unroll
    for (int o = 1; o < 64; o <<= 1) v += __shfl_xor(v, o);
    return v;
}
DI float logsigmoidf(float x) { return fminf(x, 0.f) - __logf(1.f + __expf(-fabsf(x))); }
DI float sigmoidf_(float x) { return 1.f / (1.f + __expf(-x)); }
DI float siluf_(float x) { return x / (1.f + __expf(-x)); }
DI float vloadf(const float* p) { return __builtin_bit_cast(float, __hip_atomic_load((const unsigned*)p, RLX_AGENT)); }

namespace pg8 {
constexpr int BM = 256, BK = 64, HALF = 128, HTB = HALF * BK * 2, STAGE_BYTES = 8 * HTB, NXCD = 8, WGM = 8;
__host__ __device__ __forceinline__ int lds_byte(int r, int c) { const int st = (r >> 4) * 2 + (c >> 5), rr = r & 15, cc = c & 31, ob = rr * 64 + cc * 2; return st * 1024 + (ob ^ (((ob >> 9) & 1) << 5)); }
__host__ __device__ __forceinline__ void stage_rc(int b, int& R, int& C) { const int st = b / 1024, sb = b % 1024, swz = sb ^ (((sb >> 9) & 1) << 5); R = (st >> 1) * 16 + swz / 64; C = (st & 1) * 32 + (swz % 64) / 2; }
__host__ __device__ __forceinline__ int perm32(int rho) { const int n = rho >> 4, i = rho & 15; return 8 * (i >> 2) + 4 * n + (i & 3); }

struct Unit { int pm, pn, ldc, z; size_t aoff, boff, coff; };
struct Gemm { const bf16_t* base; int lda, ldb, K; };

DI bool static_tile(int i, int G, int c, int nM, int nN, int& pm, int& pn) {
    const int nwg = nM * nN; const long L = (long)i * G + c; if (L >= nwg) return false;
    int wgid = (int)L; { const int q = nwg / NXCD, r = nwg % NXCD, xcd = wgid % NXCD, off = wgid / NXCD; wgid = (xcd < r ? xcd * (q + 1) : r * (q + 1) + (xcd - r) * q) + off; }
    const int nig = WGM * nN, gid = wgid / nig, fm = gid * WGM, gsz = (nM - fm) < WGM ? (nM - fm) : WGM;
    pm = fm + ((wgid % nig) % gsz); pn = (wgid % nig) / gsz; return true;
}
template <class Epi, class Sched, bool ALIGN_EPI>
DI void gemm_phase(LAS unsigned char* lds, const Gemm g, const Sched& S, const Epi& E) {
    const int tid = threadIdx.x, wid = __builtin_amdgcn_readfirstlane(tid >> 6), lane = tid & 63, wr = wid >> 2, wc = wid & 3, fr = lane & 15, fq = lane >> 4;
    const int K = g.K, nt = K / BK;
    unsigned voffA[2], voffB[2];
#pragma unroll
    for (int i = 0; i < 2; ++i) { int R, C; stage_rc(tid * 16 + i * 8192, R, C); const int Rb = (R & ~31) + perm32(R & 31);
        voffA[i] = (unsigned)(R * g.lda + C) * 2u; voffB[i] = (unsigned)(Rb * g.ldb + C) * 2u; }
    const size_t kstep = (size_t)(BK * 2);
    const size_t hstepA = (size_t)HALF * g.lda * 2, hstepB = (size_t)HALF * g.ldb * 2;
    const unsigned ldsw = (unsigned)wid * 1024u;
    const int aoff = lds_byte(wr * 64 + fr, fq * 8), boff = lds_byte(wc * 32 + fr, fq * 8);
#define PG8_SA(b, h) (((b) * 2 + (h)) * HTB)
#define PG8_SB(b, h) ((4 + (b) * 2 + (h)) * HTB)
#define PG8_STAGE(bufoff, gbase, voff) do { _Pragma("unroll") for (int _i = 0; _i < 2; ++_i) \
        __builtin_amdgcn_global_load_lds((const unsigned*)((const char*)(gbase) + (voff)[_i]), (LAS unsigned*)(lds + (bufoff) + ldsw + _i * 8192), 16, 0, 0); } while (0)
#define PG8_LDA(dst, b, h) do { _Pragma("unroll") for (int m = 0; m < 4; ++m) _Pragma("unroll") for (int k = 0; k < 2; ++k) dst[m][k] = *(const LAS bf16x8*)(lds + PG8_SA(b, h) + aoff + m * 2048 + k * 1024); } while (0)
#define PG8_LDB(dst, b, h) do { _Pragma("unroll") for (int n = 0; n < 2; ++n) _Pragma("unroll") for (int k = 0; k < 2; ++k) dst[n][k] = *(const LAS bf16x8*)(lds + PG8_SB(b, h) + boff + n * 2048 + k * 1024); } while (0)
#define PG8_MMA(ai, bj, At, Bt) do { __builtin_amdgcn_s_setprio(1); _Pragma("unroll") for (int m = 0; m < 4; ++m) _Pragma("unroll") for (int n = 0; n < 2; ++n) _Pragma("unroll") for (int k = 0; k < 2; ++k) \
        acc[ai][bj][m][n] = __builtin_amdgcn_mfma_f32_16x16x32_bf16(Bt[n][k], At[m][k], acc[ai][bj][m][n], 0, 0, 0); __builtin_amdgcn_s_setprio(0); } while (0)
#define PG8_WAIT_V(n) asm volatile("s_waitcnt vmcnt(" #n ")" ::: "memory")
#define PG8_WAIT_L(n) asm volatile("s_waitcnt lgkmcnt(" #n ")" ::: "memory")
#define PG8_BAR __builtin_amdgcn_s_barrier()
#define PG8_SCHED __builtin_amdgcn_sched_barrier(0)
    Unit cur, nxt; int ui = 0;
    if (!S.next(0, cur)) return;
    f32x4 acc[2][2][4][2];
#pragma unroll
    for (int a = 0; a < 2; ++a)
#pragma unroll
        for (int b = 0; b < 2; ++b)
#pragma unroll
            for (int m = 0; m < 4; ++m)
#pragma unroll
                for (int n = 0; n < 2; ++n) acc[a][b][m][n] = (f32x4){0.f, 0.f, 0.f, 0.f};
    bf16x8 At[4][2], B0[2][2], B1[2][2];
    const char* cA = (const char*)(g.base + cur.aoff); const char* cB = (const char*)(g.base + cur.boff);
    PG8_STAGE(PG8_SB(0, 0), cB, voffB); PG8_STAGE(PG8_SB(0, 1), cB + hstepB, voffB); PG8_STAGE(PG8_SA(0, 0), cA, voffA); PG8_STAGE(PG8_SA(0, 1), cA + hstepA, voffA);
    if (wr == 1) PG8_BAR;
    PG8_WAIT_V(2); PG8_BAR;
    PG8_STAGE(PG8_SB(1, 0), cB + kstep, voffB); PG8_STAGE(PG8_SA(1, 0), cA + kstep, voffA); PG8_STAGE(PG8_SB(1, 1), cB + hstepB + kstep, voffB);
    PG8_WAIT_V(6); PG8_BAR;
    for (;;) {
        const bool has_next = S.next(ui + 1, nxt);
        const char* nA = has_next ? (const char*)(g.base + nxt.aoff) : cA; const char* nB = has_next ? (const char*)(g.base + nxt.boff) : cB;
        for (int t = 0; t < nt; t += 2) {
            const bool last = (t == nt - 2);
            const char* a1 = cA + (size_t)(t + 1) * kstep;
            const char* a2 = last ? nA : cA + (size_t)(t + 2) * kstep; const char* b2 = last ? nB : cB + (size_t)(t + 2) * kstep;
            const char* a3 = a2 + kstep; const char* b3 = b2 + kstep;
            PG8_LDB(B0, 0, 0); PG8_LDB(B1, 0, 1); PG8_SCHED; PG8_LDA(At, 0, 0); PG8_STAGE(PG8_SA(1, 1), a1 + hstepA, voffA);
            PG8_WAIT_V(8); PG8_WAIT_L(0); PG8_BAR; PG8_MMA(0, 0, At, B0); PG8_MMA(0, 1, At, B1); PG8_BAR; PG8_SCHED;
            PG8_LDA(At, 0, 1); PG8_STAGE(PG8_SB(0, 0), b2, voffB); PG8_STAGE(PG8_SB(0, 1), b2 + hstepB, voffB); PG8_STAGE(PG8_SA(0, 0), a2, voffA);
            PG8_WAIT_V(8); PG8_WAIT_L(0); PG8_BAR; PG8_MMA(1, 0, At, B0); PG8_MMA(1, 1, At, B1); PG8_BAR; PG8_SCHED;
            PG8_LDB(B0, 1, 0); PG8_LDB(B1, 1, 1); PG8_SCHED; PG8_LDA(At, 1, 0); PG8_STAGE(PG8_SA(0, 1), a2 + hstepA, voffA);
            PG8_WAIT_V(8); PG8_WAIT_L(0); PG8_BAR; PG8_MMA(0, 0, At, B0); PG8_MMA(0, 1, At, B1); PG8_BAR; PG8_SCHED;
            PG8_LDA(At, 1, 1); PG8_STAGE(PG8_SB(1, 0), b3, voffB); PG8_STAGE(PG8_SB(1, 1), b3 + hstepB, voffB); PG8_STAGE(PG8_SA(1, 0), a3, voffA);
            PG8_WAIT_V(8); PG8_WAIT_L(0); PG8_BAR; PG8_MMA(1, 0, At, B0); PG8_MMA(1, 1, At, B1); PG8_BAR; PG8_SCHED;
        }
        if constexpr (ALIGN_EPI) { if (wr == 0) PG8_BAR; }
        if constexpr (!Epi::AFTER_DRAIN) { E(acc, cur, wr, wc, fr, fq); }
        if (!has_next) break;
#pragma unroll
        for (int a = 0; a < 2; ++a)
#pragma unroll
            for (int b = 0; b < 2; ++b)
#pragma unroll
                for (int m = 0; m < 4; ++m)
#pragma unroll
                    for (int n = 0; n < 2; ++n) acc[a][b][m][n] = (f32x4){0.f, 0.f, 0.f, 0.f};
        cur = nxt; cA = nA; cB = nB; ++ui;
        if constexpr (ALIGN_EPI) { if (wr == 1) PG8_BAR; }
    }
    PG8_WAIT_V(0);
    if constexpr (!ALIGN_EPI) { if (wr == 0) PG8_BAR; }
    PG8_BAR;
    if constexpr (Epi::AFTER_DRAIN) { E.fused(acc, cur, wr, wc, fr, fq, lds, wid, lane); }
#undef PG8_SA
#undef PG8_SB
#undef PG8_STAGE
#undef PG8_LDA
#undef PG8_LDB
#undef PG8_MMA
#undef PG8_WAIT_V
#undef PG8_WAIT_L
#undef PG8_BAR
#undef PG8_SCHED
}

DI void rstd_from_parts(const float* ss, int row0, int fq, float (&rs)[2][4]) {
#pragma unroll
    for (int ai = 0; ai < 2; ++ai)
#pragma unroll
        for (int m = 0; m < 4; ++m) {
            const f32x4* p = (const f32x4*)(ss + (size_t)(row0 + ai * HALF + m * 16) * 64 + fq * 16);
            const f32x4 a = p[0], b = p[1], c = p[2], d = p[3];
            float s = ((a[0] + a[1]) + (a[2] + a[3])) + ((b[0] + b[1]) + (b[2] + b[3])) + ((c[0] + c[1]) + (c[2] + c[3])) + ((d[0] + d[1]) + (d[2] + d[3]));
            s += __shfl_xor(s, 16); s += __shfl_xor(s, 32);
            rs[ai][m] = __builtin_amdgcn_rsqf(s * (1.0f / D) + EPS);
        }
}
struct EpiBf16 {
    static constexpr bool AFTER_DRAIN = false;
    bf16_t* base; const float* rstd;
    DI void operator()(const f32x4 (&acc)[2][2][4][2], const Unit& u, int wr, int wc, int fr, int fq) const {
        const int lrow = wr * 64 + fr, lcol = wc * 32 + 8 * fq;
#pragma unroll
        for (int ai = 0; ai < 2; ++ai)
#pragma unroll
            for (int m = 0; m < 4; ++m) { const int r = lrow + ai * HALF + m * 16; const float s = rstd ? rstd[u.pm * BM + r] : 1.f;
                bf16_t* rowp = base + u.coff + (size_t)r * u.ldc + lcol;
#pragma unroll
                for (int bj = 0; bj < 2; ++bj) { const f32x4 v0 = acc[ai][bj][m][0] * s, v1 = acc[ai][bj][m][1] * s;
                    u32x4 w; w.x = cvt_pk_bf16(v0[0], v0[1]); w.y = cvt_pk_bf16(v0[2], v0[3]); w.z = cvt_pk_bf16(v1[0], v1[1]); w.w = cvt_pk_bf16(v1[2], v1[3]);
                    *(u32x4*)(rowp + bj * HALF) = w; } }
    }
};
struct EpiResid {
    static constexpr bool AFTER_DRAIN = false;
    const float* resid; float* out; bf16_t* hb; float* sspart;
    DI void operator()(const f32x4 (&acc)[2][2][4][2], const Unit& u, int wr, int wc, int fr, int fq) const {
        const int row0 = u.pm * BM + wr * 64 + fr, col0 = u.pn * BM + wc * 32 + 8 * fq;
#pragma unroll
        for (int ai = 0; ai < 2; ++ai)
#pragma unroll
            for (int m = 0; m < 4; ++m) { const int row = row0 + ai * HALF + m * 16; const size_t off = (size_t)row * D + col0; float q = 0.f;
#pragma unroll
                for (int bj = 0; bj < 2; ++bj) { const f32x4 r0 = *(const f32x4*)(resid + off + bj * HALF), r1 = *(const f32x4*)(resid + off + bj * HALF + 4);
                    const f32x4 h0 = r0 + acc[ai][bj][m][0], h1 = r1 + acc[ai][bj][m][1];
                    *(f32x4*)(out + off + bj * HALF) = h0; *(f32x4*)(out + off + bj * HALF + 4) = h1;
                    q += (h0[0] * h0[0] + h0[1] * h0[1]) + (h0[2] * h0[2] + h0[3] * h0[3]) + (h1[0] * h1[0] + h1[1] * h1[1]) + (h1[2] * h1[2] + h1[3] * h1[3]);
                    if (hb) { u32x4 w; w.x = cvt_pk_bf16(h0[0], h0[1]); w.y = cvt_pk_bf16(h0[2], h0[3]); w.z = cvt_pk_bf16(h1[0], h1[1]); w.w = cvt_pk_bf16(h1[2], h1[3]);
                        *(u32x4*)(hb + off + bj * HALF) = w; } }
                q += __shfl_xor(q, 16); q += __shfl_xor(q, 32);
                if (fq == 0) sspart[(size_t)row * 64 + u.pn * 4 + wc] = q;
                asm volatile("" ::: "memory"); }
    }
};
struct EpiSwiglu {
    static constexpr bool AFTER_DRAIN = false;
    bf16_t* act; const float* sspart;
    DI void operator()(const f32x4 (&acc)[2][2][4][2], const Unit& u, int wr, int wc, int fr, int fq) const {
        const int row0 = u.pm * BM + wr * 64 + fr, col0 = u.pn * HALF + wc * 32 + 8 * fq;
        float rs[2][4]; rstd_from_parts(sspart, row0, fq, rs);
#pragma unroll
        for (int ai = 0; ai < 2; ++ai)
#pragma unroll
            for (int m = 0; m < 4; ++m) { const int row = row0 + ai * HALF + m * 16; const float r = rs[ai][m];
                float o[8];
#pragma unroll
                for (int n = 0; n < 2; ++n)
#pragma unroll
                    for (int e = 0; e < 4; ++e) { const float gt = acc[ai][0][m][n][e] * r, up = acc[ai][1][m][n][e] * r;
                        o[n * 4 + e] = gt * up * __builtin_amdgcn_rcpf(1.f + __expf(-gt)); }
                u32x4 w; w.x = cvt_pk_bf16(o[0], o[1]); w.y = cvt_pk_bf16(o[2], o[3]); w.z = cvt_pk_bf16(o[4], o[5]); w.w = cvt_pk_bf16(o[6], o[7]);
                *(u32x4*)(act + (size_t)row * FF + col0) = w; }
    }
};
struct EpiSoftmax {
    static constexpr bool AFTER_DRAIN = true;
    bf16_t* P; const float* sspart;
    DI void operator()(const f32x4 (&)[2][2][4][2], const Unit&, int, int, int, int) const {}
    DI void fused(f32x4 (&acc)[2][2][4][2], const Unit& u, int wr, int wc, int fr, int fq, LAS unsigned char* lds, int wid, int lane) const {
        const int lrow = wr * 64 + fr, row0 = u.pm * BM + lrow;
        float rs[2][4]; rstd_from_parts(sspart, row0, fq, rs);
        LAS f32x2* T = (LAS f32x2*)lds;
        float mw[2][4];
#pragma unroll
        for (int ai = 0; ai < 2; ++ai)
#pragma unroll
            for (int m = 0; m < 4; ++m) { const float sc = rs[ai][m] * (0.03125f * 1.4426950408889634f); float mx = -3.0e38f;
#pragma unroll
                for (int bj = 0; bj < 2; ++bj)
#pragma unroll
                    for (int n = 0; n < 2; ++n) { acc[ai][bj][m][n] = acc[ai][bj][m][n] * sc; const f32x4 x = acc[ai][bj][m][n]; mx = fmaxf(fmaxf(mx, fmaxf(x[0], x[1])), fmaxf(x[2], x[3])); }
                mx = fmaxf(mx, __shfl_xor(mx, 16)); mx = fmaxf(mx, __shfl_xor(mx, 32)); float l = 0.f;
#pragma unroll
                for (int bj = 0; bj < 2; ++bj)
#pragma unroll
                    for (int n = 0; n < 2; ++n) { f32x4 x = acc[ai][bj][m][n];
#pragma unroll
                        for (int e = 0; e < 4; ++e) { x[e] = __builtin_amdgcn_exp2f(x[e] - mx); l += x[e]; }
                        acc[ai][bj][m][n] = x; }
                l += __shfl_xor(l, 16); l += __shfl_xor(l, 32);
                mw[ai][m] = mx;
                if (fq == 0) T[(lrow + ai * HALF + m * 16) * 4 + wc] = (f32x2){mx, l}; }
        asm volatile("s_waitcnt lgkmcnt(0)" ::: "memory"); __builtin_amdgcn_s_barrier(); asm volatile("" ::: "memory");
        const int lcol = u.pn * BM + wc * 32 + 8 * fq;
#pragma unroll
        for (int ai = 0; ai < 2; ++ai)
#pragma unroll
            for (int m = 0; m < 4; ++m) { const int r = lrow + ai * HALF + m * 16;
                const f32x2 a = T[r * 4 + 0], b = T[r * 4 + 1], c = T[r * 4 + 2], d = T[r * 4 + 3];
                const float mx = fmaxf(fmaxf(a.x, b.x), fmaxf(c.x, d.x));
                const float L = a.y * __builtin_amdgcn_exp2f(a.x - mx) + b.y * __builtin_amdgcn_exp2f(b.x - mx) + c.y * __builtin_amdgcn_exp2f(c.x - mx) + d.y * __builtin_amdgcn_exp2f(d.x - mx);
                const float f = __builtin_amdgcn_exp2f(mw[ai][m] - mx) / L;
                bf16_t* rowp = P + (size_t)(u.pm * BM + r) * 1024 + lcol;
#pragma unroll
                for (int bj = 0; bj < 2; ++bj) { const f32x4 v0 = acc[ai][bj][m][0] * f, v1 = acc[ai][bj][m][1] * f;
                    u32x4 w; w.x = cvt_pk_bf16(v0[0], v0[1]); w.y = cvt_pk_bf16(v0[2], v0[3]); w.z = cvt_pk_bf16(v1[0], v1[1]); w.w = cvt_pk_bf16(v1[2], v1[3]);
                    *(u32x4*)(rowp + bj * HALF) = w; } }
    }
};
}

#define XB_TMO      128
#define XB_XCNT(j)  (256  + 64 * (j))
#define XB_XSUB(j)  (1280 + 64 * (j))
#define XB_XGEN(j)  (2304 + 64 * (j))
#define XB_TOP      3328
#define XB_TOPGEN   3392
#define XCD_BAR_WORDS 3456
#define XB_SPIN_CAP (1u << 18)
__device__ __forceinline__ unsigned xb_ld(unsigned* p)              { return __hip_atomic_load(p, __ATOMIC_RELAXED, __HIP_MEMORY_SCOPE_AGENT); }
__device__ __forceinline__ unsigned xb_add(unsigned* p, unsigned v) { return __hip_atomic_fetch_add(p, v, __ATOMIC_RELAXED, __HIP_MEMORY_SCOPE_AGENT); }
__device__ __forceinline__ unsigned xb_xcc_id() { return (unsigned)__builtin_amdgcn_s_getreg((3 << 11) | 20) & 0xFu; }
#define XB_SPIN(cond, bar) do { unsigned _sp = 0; while (cond) { __builtin_amdgcn_s_sleep(1); \
    if ((++_sp & 255u) == 0u) { if (xb_ld(&(bar)[XB_TMO])) break; if (_sp > XB_SPIN_CAP) { atomicAdd(&(bar)[XB_TMO], 1u); break; } } } } while (0)
struct XcdBarrier { unsigned* bar; unsigned x; volatile LAS unsigned* st; };
__device__ __forceinline__ XcdBarrier xcd_barrier_post(unsigned* bar, volatile LAS unsigned* st) {
    XcdBarrier b; b.bar = bar; b.x = xb_xcc_id(); b.st = st;
    if (threadIdx.x == 0) (void)xb_add(&bar[XB_XCNT(b.x)], 1u);
    return b;
}
__device__ __forceinline__ void xcd_barrier_complete(unsigned* bar, unsigned x, unsigned& nloc, unsigned& nx) {
    const unsigned G = gridDim.x * gridDim.y * gridDim.z;
    unsigned sum, cnt, mine, sp = 0u;
    for (;;) {
        sum = 0u; cnt = 0u; mine = 0u;
#pragma unroll
        for (unsigned j = 0; j < 16; ++j) { const unsigned c = xb_ld(&bar[XB_XCNT(j)]); sum += c; cnt += (c > 0u) ? 1u : 0u; mine = (j == x) ? c : mine; }
        if (sum == G) break;
        __builtin_amdgcn_s_sleep(1);
        if ((++sp & 255u) == 0u) { if (xb_ld(&bar[XB_TMO])) break; if (sp > XB_SPIN_CAP) { atomicAdd(&bar[XB_TMO], 1u); break; } }
    }
    nloc = mine > 0u ? mine : 1u; nx = cnt > 0u ? cnt : 1u;
}
__device__ __forceinline__ void xcd_barrier(const XcdBarrier& b) {
    asm volatile("s_waitcnt vmcnt(0)" ::: "memory");
    __syncthreads();
    if (threadIdx.x == 0) {
        unsigned* bar = b.bar;
        __builtin_amdgcn_s_waitcnt(0);
        unsigned nloc = b.st[0], nx = b.st[1];
        if (nloc == 0u) { xcd_barrier_complete(bar, b.x, nloc, nx); b.st[0] = nloc; b.st[1] = nx; }
        const unsigned old = xb_add(&bar[XB_XSUB(b.x)], 1u);
        const unsigned gen = old / nloc;
        if (old + 1u == (gen + 1u) * nloc) {
            __builtin_amdgcn_fence(__ATOMIC_RELEASE, "agent");
            asm volatile("s_waitcnt vmcnt(0)" ::: "memory");
            const unsigned og = xb_add(&bar[XB_TOP], 1u);
            const unsigned tg = og / nx;
            if (og + 1u == (tg + 1u) * nx) xb_add(&bar[XB_TOPGEN], 1u);
            else XB_SPIN(xb_ld(&bar[XB_TOPGEN]) == tg, bar);
            __builtin_amdgcn_fence(__ATOMIC_ACQUIRE, "agent");
            xb_add(&bar[XB_XGEN(b.x)], 1u);
            asm volatile("s_waitcnt vmcnt(0)" ::: "memory");
        } else {
            XB_SPIN(xb_ld(&bar[XB_XGEN(b.x)]) == gen, bar);
            __builtin_amdgcn_fence(__ATOMIC_ACQUIRE, "agent");
            asm volatile("s_waitcnt vmcnt(0)" ::: "memory");
        }
    }
    __syncthreads();
}

struct Args { const float* in[24]; float* out; unsigned char* ws; int ph_lo, ph_hi; };
enum { IN_X = 0, IN_MEM, IN_NMIXG, IN_WIN, IN_GW2, IN_GB, IN_GNORM, IN_CONVW, IN_CONVB, IN_IGB, IN_FGB, IN_MNORM, IN_WOUT, IN_NCROSSG, IN_NMEMG,
       IN_WQ, IN_WK, IN_WV, IN_WO, IN_NFFNG, IN_WGATE, IN_WUP, IN_WDOWN, IN_NFING };

struct Frame {
    LAS unsigned char* lds;
    unsigned char* ws;
    int tid, lane, wave, vcu, G, bx;
};

DI void cvt_tile_T(const float* W, int ldw, int k0, int sc0, bf16_t* Wt, int K, int dr0, const float* g, int lane) {
    const int kq = lane >> 4, nl = lane & 15;
    f32x4 v[16];
    const float* src = W + (size_t)(k0 + 16 * kq) * ldw + sc0 + 4 * nl;
#pragma unroll
    for (int i = 0; i < 16; ++i) v[i] = *(const f32x4*)(src + (size_t)i * ldw);
    if (g) {
        const f32x4* gp = (const f32x4*)(g + k0 + 16 * kq);
#pragma unroll
        for (int q = 0; q < 4; ++q) { const f32x4 gv = gp[q];
#pragma unroll
            for (int e = 0; e < 4; ++e) v[4 * q + e] = v[4 * q + e] * gv[e]; }
    }
#pragma unroll
    for (int e = 0; e < 4; ++e) {
        u32x4 lo, hi;
        lo.x = pk2(v[0][e], v[1][e]); lo.y = pk2(v[2][e], v[3][e]); lo.z = pk2(v[4][e], v[5][e]); lo.w = pk2(v[6][e], v[7][e]);
        hi.x = pk2(v[8][e], v[9][e]); hi.y = pk2(v[10][e], v[11][e]); hi.z = pk2(v[12][e], v[13][e]); hi.w = pk2(v[14][e], v[15][e]);
        bf16_t* dst = Wt + (size_t)(dr0 + 4 * nl + e) * K + k0 + 16 * kq;
        *(u32x4*)dst = lo; *(u32x4*)(dst + 8) = hi;
    }
}
DI void p0a_weights(const Frame& F, const Args& a) {
    const int gw = F.vcu * NWAVES + F.wave, NGW = F.G * NWAVES, lane = F.lane;
    unsigned char* ws = F.ws;
    constexpr int I_WIN = 64 * 192, I_SQ = 64 * 64, I_WGU = 64 * 344, I_WDN = 172 * 64;
    constexpr int NITEMS = I_WIN + 4 * I_SQ + I_WGU + I_WDN;
    for (int it = gw; it < NITEMS; it += NGW) {
        int r = it;
        if (r < I_WIN) { const int kb = r / 192, nb = r % 192, n0 = 64 * nb; cvt_tile_T(a.in[IN_WIN], INCOLS, 64 * kb, n0 < 6144 ? n0 : n0 + 16, (bf16_t*)(ws + WS_WIN), D, n0, a.in[IN_NMIXG], lane); continue; } r -= I_WIN;
        if (r < I_SQ) { cvt_tile_T(a.in[IN_WOUT], D, 64 * (r / 64), 64 * (r % 64), (bf16_t*)(ws + WS_WOUT), D, 64 * (r % 64), nullptr, lane); continue; } r -= I_SQ;
        if (r < I_SQ) { cvt_tile_T(a.in[IN_WK], D, 64 * (r / 64), 64 * (r % 64), (bf16_t*)(ws + WS_WK), D, 64 * (r % 64), nullptr, lane); continue; } r -= I_SQ;
        if (r < I_SQ) { cvt_tile_T(a.in[IN_WV], D, 64 * (r / 64), 64 * (r % 64), (bf16_t*)(ws + WS_WV), D, 64 * (r % 64), nullptr, lane); continue; } r -= I_SQ;
        if (r < I_SQ) { cvt_tile_T(a.in[IN_WO], D, 64 * (r / 64), 64 * (r % 64), (bf16_t*)(ws + WS_WO), D, 64 * (r % 64), nullptr, lane); continue; } r -= I_SQ;
        if (r < I_WGU) { const int kb = r / 344, nb = r % 344, n0 = 64 * nb, pn = n0 >> 8, j0 = n0 & 255;
            cvt_tile_T(j0 < 128 ? a.in[IN_WGATE] : a.in[IN_WUP], FF, 64 * kb, 128 * pn + (j0 & 127), (bf16_t*)(ws + WS_WGU), D, n0, a.in[IN_NFFNG], lane); continue; } r -= I_WGU;
        { const int kb = r / 64, nb = r % 64; cvt_tile_T(a.in[IN_WDOWN], D, 64 * kb, 64 * nb, (bf16_t*)(ws + WS_WDN), FF, 64 * nb, nullptr, lane); }
    }
    { const float* wq = a.in[IN_WQ]; const float* g = a.in[IN_NCROSSG]; bf16_t* o = (bf16_t*)(ws + WS_WQ);
      const size_t n8 = (size_t)D * D / 8, stride = (size_t)F.G * 512;
      for (size_t i = (size_t)F.vcu * 512 + F.tid; i < n8; i += stride) { const f32x4 x0 = *(const f32x4*)(wq + i * 8), x1 = *(const f32x4*)(wq + i * 8 + 4); const float gg = g[(i * 8) >> 12];
          u32x4 w; w.x = pk2(x0[0] * gg, x0[1] * gg); w.y = pk2(x0[2] * gg, x0[3] * gg); w.z = pk2(x1[0] * gg, x1[1] * gg); w.w = pk2(x1[2] * gg, x1[3] * gg);
          *(u32x4*)(o + i * 8) = w; } }
    { const float* win = a.in[IN_WIN]; const float* g = a.in[IN_NMIXG]; bf16_t* o = (bf16_t*)(ws + WS_WSMALL);
      for (int i = F.vcu * 512 + F.tid; i < 32 * D; i += F.G * 512) { const int c = i >> 12, k = i & (D - 1);
          float v = 0.f; if (c < 24) { const int col = c < 16 ? 6144 + c : 12304 + (c - 16); v = win[(size_t)k * INCOLS + col] * g[k]; }
          o[i] = (bf16_t)f2bf(v); } }
    { const float* mem = a.in[IN_MEM]; const float* g = a.in[IN_NMEMG]; bf16_t* o = (bf16_t*)(ws + WS_MEMN);
      for (int row = gw; row < 512; row += NGW) { const f32x4* xr = (const f32x4*)(mem + (size_t)row * D) + lane; f32x4 v[16]; float s = 0.f;
#pragma unroll
          for (int j = 0; j < 16; ++j) { v[j] = xr[64 * j]; s += (v[j][0] * v[j][0] + v[j][1] * v[j][1]) + (v[j][2] * v[j][2] + v[j][3] * v[j][3]); }
          const float rstd = __builtin_amdgcn_rsqf(wave_sum(s) * (1.f / D) + EPS);
#pragma unroll
          for (int j = 0; j < 16; ++j) { const f32x4 gv = *((const f32x4*)g + lane + 64 * j); const f32x4 y = v[j] * rstd * gv;
              u32x2 w; w.x = pk2(y[0], y[1]); w.y = pk2(y[2], y[3]); *((u32x2*)(o + (size_t)row * D) + lane + 64 * j) = w; } } }
}

DI void p0b_x(const Frame& F, const Args& a) {
    const int gw = F.vcu * NWAVES + F.wave, NGW = F.G * NWAVES, lane = F.lane, r = lane & 15, q4 = lane >> 4;
    const float* x = a.in[IN_X]; unsigned char* ws = F.ws;
    bf16_t* xb = (bf16_t*)(ws + WS_XB); const bf16_t* wsm = (const bf16_t*)(ws + WS_WSMALL); float* rstd0 = (float*)(ws + WS_RSTD0); float* smallp = (float*)(ws + WS_SMALLP);
    for (int task = gw; task < M / 16; task += NGW) {
        const int R0 = task * 16;
        const float* xr = x + (size_t)(R0 + r) * D + 8 * q4; bf16_t* xo = xb + (size_t)(R0 + r) * D + 8 * q4;
        const bf16_t* w0 = wsm + (size_t)r * D + 8 * q4; const bf16_t* w1 = w0 + (size_t)16 * D;
        f32x4 acc0 = {0.f, 0.f, 0.f, 0.f}, acc1 = {0.f, 0.f, 0.f, 0.f}; float ss = 0.f;
        for (int s0 = 0; s0 < 128; s0 += 4) {
            f32x4 xa[4], xc[4]; bf16x8 b0[4], b1[4];
#pragma unroll
            for (int u = 0; u < 4; ++u) { xa[u] = *(const f32x4*)(xr + 32 * (s0 + u)); xc[u] = *(const f32x4*)(xr + 32 * (s0 + u) + 4);
                b0[u] = *(const bf16x8*)(w0 + 32 * (s0 + u)); b1[u] = *(const bf16x8*)(w1 + 32 * (s0 + u)); }
#pragma unroll
            for (int u = 0; u < 4; ++u) { const f32x4 p = xa[u], q = xc[u];
                ss += (p[0] * p[0] + p[1] * p[1]) + (p[2] * p[2] + p[3] * p[3]) + (q[0] * q[0] + q[1] * q[1]) + (q[2] * q[2] + q[3] * q[3]);
                u32x4 w; w.x = pk2(p[0], p[1]); w.y = pk2(p[2], p[3]); w.z = pk2(q[0], q[1]); w.w = pk2(q[2], q[3]);
                *(u32x4*)(xo + 32 * (s0 + u)) = w; const bf16x8 af = __builtin_bit_cast(bf16x8, w);
                acc0 = __builtin_amdgcn_mfma_f32_16x16x32_bf16(af, b0[u], acc0, 0, 0, 0); acc1 = __builtin_amdgcn_mfma_f32_16x16x32_bf16(af, b1[u], acc1, 0, 0, 0); }
        }
        ss += __shfl_xor(ss, 16); ss += __shfl_xor(ss, 32);
        const float rstd = __builtin_amdgcn_rsqf(ss * (1.f / D) + EPS);
        if (q4 == 0) rstd0[R0 + r] = rstd;
#pragma unroll
        for (int reg = 0; reg < 4; ++reg) { const int row = 4 * q4 + reg; const float rsr = __shfl(rstd, row);
            smallp[(size_t)(R0 + row) * 32 + r] = acc0[reg] * rsr; smallp[(size_t)(R0 + row) * 32 + 16 + r] = acc1[reg] * rsr; }
    }
}

constexpr int QT_STRIDE = 528;
constexpr int PRE_QT = 0, PRE_KT = 64 * QT_STRIDE, PRE_PT = 2 * 64 * QT_STRIDE, PT_STRIDE = 272;
constexpr int PRE_MISC = PRE_PT + 64 * PT_STRIDE;
template <bool ML>
DI void pre_item(const Frame& F, const Args& a, int s, int n) {
    LAS unsigned char* lds = F.lds; unsigned char* ws = F.ws;
    const int tid = F.tid, lane = F.lane, wave = F.wave;
    const int b = (s >> 2) & 1, h = s & 3, sl = s & 7;
    const int T0 = b * SEQ + n * 64;
    const bf16_t* proj = (const bf16_t*)(ws + WS_PROJ); const float* smallp = (const float*)(ws + WS_SMALLP);
    LAS float* AG = (LAS float*)(lds + PRE_MISC); LAS float* HT = AG + 1024; LAS float* BB = HT + 256; LAS float* UU = BB + 64; LAS float* MLc = UU + 64; LAS float* WL = MLc + 64;
    const int d = tid & 255, th = tid >> 8;
    if (!ML) {
        if (tid < 256) { const int t = tid >> 2, r4 = tid & 3; *(LAS f32x4*)(AG + t * 16 + 4 * r4) = *(const f32x4*)(smallp + (size_t)(T0 + t) * 32 + 4 * r4); }
        __syncthreads();
        float w2c[16]; const float* w2 = a.in[IN_GW2];
#pragma unroll
        for (int r = 0; r < 16; ++r) w2c[r] = w2[r * 1024 + h * 256 + d];
        const float gb = a.in[IN_GB][h * 256 + d];
        float la[32]; float run = 0.f;
#pragma unroll
        for (int i = 0; i < 32; ++i) { const int t = 32 * th + i; float xg = gb;
#pragma unroll
            for (int q = 0; q < 4; ++q) { const f32x4 av = *(const LAS f32x4*)(AG + t * 16 + 4 * q); xg += av[0] * w2c[4 * q] + av[1] * w2c[4 * q + 1] + av[2] * w2c[4 * q + 2] + av[3] * w2c[4 * q + 3]; }
            la[i] = logsigmoidf(xg) * 0.0625f; run += la[i]; }
        if (th == 0) HT[d] = run;
        __syncthreads();
        float bc = th ? HT[d] : 0.f;
        const bf16_t* qp = proj + (size_t)(T0 + 32 * th) * NPROJ + C_QG + h * 256 + d; const bf16_t* kp = proj + (size_t)(T0 + 32 * th) * NPROJ + C_KG + h * 256 + d;
#pragma unroll
        for (int i = 0; i < 32; ++i) { const int t = 32 * th + i; bc += la[i];
            const float qv = bf2f(qp[(size_t)i * NPROJ]), kv = bf2f(kp[(size_t)i * NPROJ]);
            *(LAS bf16_t*)(lds + PRE_QT + t * QT_STRIDE + 2 * d) = (bf16_t)f2bf(qv * 0.0625f * __expf(bc));
            *(LAS bf16_t*)(lds + PRE_KT + t * QT_STRIDE + 2 * d) = (bf16_t)f2bf(kv * __expf(-bc)); }
        if (th == 1) ((float*)(ws + WS_DEC))[((size_t)sl * NCH + n) * 256 + d] = __expf(bc);
    } else {
        float* mst = (float*)(ws + WS_MST) + ((size_t)sl * NCH + n) * 256;
        if (wave == 0) { const int t = lane;
            const float im = smallp[(size_t)(T0 + t) * 32 + 16 + h], fm = smallp[(size_t)(T0 + t) * 32 + 20 + h];
            const float ib = im + a.in[IN_IGB][h], lf = logsigmoidf(fm + a.in[IN_FGB][h]);
            float bb = lf;
#pragma unroll
            for (int o = 1; o < 64; o <<= 1) { const float y = __shfl_up(bb, o); if (lane >= o) bb += y; }
            const float u = ib - bb; float cm = u;
#pragma unroll
            for (int o = 1; o < 64; o <<= 1) { const float y = __shfl_up(cm, o); if (lane >= o) cm = fmaxf(cm, y); }
            const float blast = __shfl(bb, 63), cmax = __shfl(cm, 63);
            BB[t] = bb; UU[t] = u; MLc[t] = bb + cm; WL[t] = __expf(u - cmax);
            mst[t] = bb; mst[64 + t] = bb + cm; if (t == 0) { mst[192] = blast; mst[193] = blast + cmax; }
        }
        __syncthreads();
        const float* cw = a.in[IN_CONVW]; const float* cb = a.in[IN_CONVB];
        const int chq = h * 256 + d, chk = 1024 + h * 256 + d;
        float wq[4], wk[4];
#pragma unroll
        for (int j = 0; j < 4; ++j) { wq[j] = cw[j * 2048 + chq]; wk[j] = cw[j * 2048 + chk]; }
        const float bq = cb[chq], bk = cb[chk];
        const int tfirst = 32 * th;
        const bf16_t* qp = proj + (size_t)(T0 + tfirst) * NPROJ + C_QM + h * 256 + d; const bf16_t* kp = proj + (size_t)(T0 + tfirst) * NPROJ + C_KM + h * 256 + d;
        float xq[3], xk[3];
        const bool hist = (n > 0) || (th > 0);
#pragma unroll
        for (int j = 0; j < 3; ++j) { xq[j] = hist ? bf2f(*(qp - (size_t)(3 - j) * NPROJ)) : 0.f; xk[j] = hist ? bf2f(*(kp - (size_t)(3 - j) * NPROJ)) : 0.f; }
        float ks = 0.f;
#pragma unroll
        for (int i = 0; i < 32; ++i) { const int t = tfirst + i;
            const float cq = bf2f(qp[(size_t)i * NPROJ]), ck = bf2f(kp[(size_t)i * NPROJ]);
            const float yq = bq + wq[0] * xq[0] + wq[1] * xq[1] + wq[2] * xq[2] + wq[3] * cq;
            const float yk = bk + wk[0] * xk[0] + wk[1] * xk[1] + wk[2] * xk[2] + wk[3] * ck;
            xq[0] = xq[1]; xq[1] = xq[2]; xq[2] = cq; xk[0] = xk[1]; xk[1] = xk[2]; xk[2] = ck;
            const float qv = siluf_(yq), kv = siluf_(yk) * 0.0625f;
            const unsigned kb16 = f2bf(kv);
            *(LAS bf16_t*)(lds + PRE_QT + t * QT_STRIDE + 2 * d) = (bf16_t)f2bf(qv);
            *(LAS bf16_t*)(lds + PRE_KT + t * QT_STRIDE + 2 * d) = (bf16_t)kb16;
            ks += bflo(kb16) * WL[t]; }
        if (th == 0) HT[d] = ks;
        __syncthreads();
        if (th == 1) ((float*)(ws + WS_KSUM))[((size_t)sl * NCH + n) * 256 + d] = ks + HT[d];
    }
    __syncthreads();
    bf16_t* Aq = (bf16_t*)(ws + (ML ? WS_AQM : WS_AQG)) + ((size_t)sl * NCH + n) * 16384;
    bf16_t* Ak = (bf16_t*)(ws + (ML ? WS_AKM : WS_AKG)) + ((size_t)sl * NCH + n) * 16384;
    bf16_t* Pm = (bf16_t*)(ws + (ML ? WS_PMM : WS_PMG)) + ((size_t)sl * NCH + n) * 4096;
#pragma unroll
    for (int i = 0; i < 4; ++i) { const int p = tid + 512 * i, w = p >> 8, tb = (p >> 7) & 1, ks = (p >> 6) & 1, l = p & 63, r = l & 31, hh = l >> 5;
        const int t = 32 * tb + r, d0 = 32 * w + 16 * ks + 4 * hh;
        const u32x2 lo = *(const LAS u32x2*)(lds + PRE_QT + t * QT_STRIDE + 2 * d0), hi = *(const LAS u32x2*)(lds + PRE_QT + t * QT_STRIDE + 2 * (d0 + 8));
        *(u32x4*)(Aq + (size_t)p * 8) = (u32x4){lo.x, lo.y, hi.x, hi.y}; }
#pragma unroll
    for (int i = 0; i < 4; ++i) { const int p = tid + 512 * i, w = p >> 8, ks4 = (p >> 6) & 3, l = p & 63, r = l & 31, hh = l >> 5;
        const int dd = 32 * w + r, t0 = 16 * ks4 + 8 * hh; float kv[8];
#pragma unroll
        for (int j = 0; j < 8; ++j) { kv[j] = bf2f(*(const LAS bf16_t*)(lds + PRE_KT + (t0 + j) * QT_STRIDE + 2 * dd)); if (ML) kv[j] *= WL[t0 + j]; }
        u32x4 o; o.x = pk2(kv[0], kv[1]); o.y = pk2(kv[2], kv[3]); o.z = pk2(kv[4], kv[5]); o.w = pk2(kv[6], kv[7]);
        *(u32x4*)(Ak + (size_t)p * 8) = o; }
    { const int r16 = lane & 15, q4 = lane >> 4, tt = wave >> 1;
#pragma unroll
      for (int e2 = 0; e2 < 2; ++e2) { const int st = 2 * (wave & 1) + e2; f32x4 c = {0.f, 0.f, 0.f, 0.f};
          if (st <= tt) {
#pragma unroll
              for (int k = 0; k < 8; ++k) { const bf16x8 af = *(const LAS bf16x8*)(lds + PRE_QT + (16 * tt + r16) * QT_STRIDE + 2 * (32 * k + 8 * q4));
                  const bf16x8 bfr = *(const LAS bf16x8*)(lds + PRE_KT + (16 * st + r16) * QT_STRIDE + 2 * (32 * k + 8 * q4));
                  c = __builtin_amdgcn_mfma_f32_16x16x32_bf16(af, bfr, c, 0, 0, 0); } }
          const int scol = 16 * st + r16;
#pragma unroll
          for (int reg = 0; reg < 4; ++reg) { const int t = 16 * tt + 4 * q4 + reg; float v = (scol <= t) ? c[reg] : 0.f;
              if (ML) v = (scol <= t) ? v * __expf(BB[t] - MLc[t] + UU[scol]) : 0.f;
              *(LAS float*)(lds + PRE_PT + t * PT_STRIDE + 4 * scol) = v; } } }
    __syncthreads();
    if (ML && tid < 64) { float rsum = 0.f;
#pragma unroll 8
        for (int j = 0; j < 64; ++j) rsum += *(const LAS float*)(lds + PRE_PT + tid * PT_STRIDE + 4 * j);
        ((float*)(ws + WS_MST))[((size_t)sl * NCH + n) * 256 + 128 + tid] = rsum; }
    { const int p = tid, tb = p >> 8, ks4 = (p >> 6) & 3, l = p & 63, r = l & 31, hh = l >> 5; const int t = 32 * tb + r, s0 = 16 * ks4 + 8 * hh;
      const f32x4 x0 = *(const LAS f32x4*)(lds + PRE_PT + t * PT_STRIDE + 4 * s0), x1 = *(const LAS f32x4*)(lds + PRE_PT + t * PT_STRIDE + 4 * (s0 + 4));
      u32x4 o; o.x = pk2(x0[0], x0[1]); o.y = pk2(x0[2], x0[3]); o.z = pk2(x1[0], x1[1]); o.w = pk2(x1[2], x1[3]);
      *(u32x4*)(Pm + (size_t)p * 8) = o; }
    __syncthreads();
}

DI bf16x8 pack8(float a0, float a1, float a2, float a3, float a4, float a5, float a6, float a7) {
    u32x4 p;
    asm volatile("v_cvt_pk_bf16_f32 %0, %4, %5\n\tv_cvt_pk_bf16_f32 %1, %6, %7\n\tv_cvt_pk_bf16_f32 %2, %8, %9\n\tv_cvt_pk_bf16_f32 %3, %10, %11\n\ts_nop 1"
                 : "=&v"(p[0]), "=&v"(p[1]), "=&v"(p[2]), "=&v"(p[3]) : "v"(a0), "v"(a1), "v"(a2), "v"(a3), "v"(a4), "v"(a5), "v"(a6), "v"(a7));
    return __builtin_bit_cast(bf16x8, p);
}
#define MFMA32(a, b, c) __builtin_amdgcn_mfma_f32_32x32x16_bf16((a), (b), (c), 0, 0, 0)
template <bool ML>
DI void scan_stream(const Frame& F, const Args& a, int s, int slice) {
    LAS unsigned char* lds = F.lds; unsigned char* ws = F.ws;
    const int tid = F.tid, lane = F.lane, w = F.wave, c = lane & 31, hh = lane >> 5;
    const int b = (s >> 2) & 1, h = s & 3, sl = s & 7;
    const size_t T0 = (size_t)b * SEQ;
    const bf16_t* proj = (const bf16_t*)(ws + WS_PROJ);
    const int vcol = (ML ? C_VM : C_VG) + h * 512 + 32 * slice;
    bf16_t* outp = (bf16_t*)(ws + (ML ? WS_OUTM : WS_OUTG)) + h * 512 + 32 * slice + c;
    const u32x4* AqS = (const u32x4*)(ws + (ML ? WS_AQM : WS_AQG)) + (size_t)sl * NCH * 2048 + w * 256 + lane;
    const u32x4* AkS = (const u32x4*)(ws + (ML ? WS_AKM : WS_AKG)) + (size_t)sl * NCH * 2048 + w * 256 + lane;
    const u32x4* PmS = (const u32x4*)(ws + (ML ? WS_PMM : WS_PMG)) + (size_t)sl * NCH * 512 + ((w & 1) * 4 + (w >> 1)) * 64 + lane;
    const float* decS = (const float*)(ws + WS_DEC) + (size_t)sl * NCH * 256 + 32 * w + 4 * hh;
    const float* mstS = (const float*)(ws + WS_MST) + (size_t)sl * NCH * 256;
    const float* ksumS = (const float*)(ws + WS_KSUM) + (size_t)sl * NCH * 256 + 32 * w + c;
    float* nprevS = (float*)(ws + WS_NPREV) + (size_t)sl * NCH * 256 + 32 * w + c;
    float* denS = (float*)(ws + WS_DENAUX) + (size_t)sl * NCH * 192;
    LAS unsigned char* vbuf = lds + LDS_X0;
    LAS float* eg = (LAS float*)(lds + LDS_X1) + w * 128;
    const unsigned vaddr = (unsigned)(size_t)vbuf + (8 * hh + ((lane & 15) >> 2)) * 64 + 32 * ((lane >> 4) & 1) + 8 * (lane & 3);
    const bf16_t* vsrc = proj + (T0 + (tid >> 2)) * NPROJ + vcol + 8 * (tid & 3);
    f32x16 S;
#pragma unroll
    for (int i = 0; i < 16; ++i) S[i] = 0.f;
    float m_prev = 0.f, nreg = 0.f;
    u32x4 cAq[4], cAk[4], cPm; f32x4 cdec[4]; float cbb = 0.f, cml = 0.f, csc = 0.f, cks = 0.f;
#pragma unroll
    for (int f = 0; f < 4; ++f) { cAq[f] = AqS[f * 64]; cAk[f] = AkS[f * 64]; }
    cPm = PmS[0];
    if (!ML) {
#pragma unroll
        for (int g = 0; g < 4; ++g) cdec[g] = *(const f32x4*)(decS + 8 * g);
    } else { cbb = mstS[lane]; cml = mstS[64 + lane]; csc = mstS[192 + (lane & 1)]; if (slice == 0) cks = ksumS[0]; }
    if (tid < 256) { const u32x4 v0 = *(const u32x4*)vsrc; *(LAS u32x4*)(vbuf + tid * 16) = v0; }
    __syncthreads();
    for (int n = 0; n < NCH; ++n) {
        const bool more = (n + 1 < NCH);
        u32x4 nAq[4], nAk[4], nPm, nv; f32x4 ndec[4]; float nbb = 0.f, nml = 0.f, nsc = 0.f, nks = 0.f;
        { const size_t o = more ? (size_t)(n + 1) : (size_t)n;
#pragma unroll
          for (int f = 0; f < 4; ++f) { nAq[f] = AqS[o * 2048 + f * 64]; nAk[f] = AkS[o * 2048 + f * 64]; }
          nPm = PmS[o * 512];
          if (!ML) {
#pragma unroll
              for (int g = 0; g < 4; ++g) ndec[g] = *(const f32x4*)(decS + o * 256 + 8 * g);
          } else { nbb = mstS[o * 256 + lane]; nml = mstS[o * 256 + 64 + lane]; nsc = mstS[o * 256 + 192 + (lane & 1)]; if (slice == 0) nks = ksumS[o * 256]; }
          if (tid < 256) nv = *(const u32x4*)(vsrc + o * 64 * NPROJ); }
        u32x2 tv[8];
        { const unsigned va = vaddr + (n & 1) * 4096;
          asm volatile("ds_read_b64_tr_b16 %0, %8\n\tds_read_b64_tr_b16 %1, %8 offset:256\n\tds_read_b64_tr_b16 %2, %8 offset:1024\n\tds_read_b64_tr_b16 %3, %8 offset:1280\n\t"
                       "ds_read_b64_tr_b16 %4, %8 offset:2048\n\tds_read_b64_tr_b16 %5, %8 offset:2304\n\tds_read_b64_tr_b16 %6, %8 offset:3072\n\tds_read_b64_tr_b16 %7, %8 offset:3328\n\t"
                       "s_waitcnt lgkmcnt(0)"
                       : "=&v"(tv[0]), "=&v"(tv[1]), "=&v"(tv[2]), "=&v"(tv[3]), "=&v"(tv[4]), "=&v"(tv[5]), "=&v"(tv[6]), "=&v"(tv[7]) : "v"(va) : "memory"); }
        bf16x8 Bv[4];
#pragma unroll
        for (int k = 0; k < 4; ++k) Bv[k] = __builtin_bit_cast(bf16x8, (u32x4){tv[2 * k].x, tv[2 * k].y, tv[2 * k + 1].x, tv[2 * k + 1].y});
        const bf16x8 Bs0 = pack8(S[0], S[1], S[2], S[3], S[4], S[5], S[6], S[7]);
        const bf16x8 Bs1 = pack8(S[8], S[9], S[10], S[11], S[12], S[13], S[14], S[15]);
        f32x16 zero;
#pragma unroll
        for (int i = 0; i < 16; ++i) zero[i] = 0.f;
        f32x16 o0 = MFMA32(__builtin_bit_cast(bf16x8, cAq[0]), Bs0, zero); o0 = MFMA32(__builtin_bit_cast(bf16x8, cAq[1]), Bs1, o0);
        f32x16 o1 = MFMA32(__builtin_bit_cast(bf16x8, cAq[2]), Bs0, zero); o1 = MFMA32(__builtin_bit_cast(bf16x8, cAq[3]), Bs1, o1);
        const f32x16 pi = MFMA32(__builtin_bit_cast(bf16x8, cPm), (w >> 1) == 0 ? Bv[0] : (w >> 1) == 1 ? Bv[1] : (w >> 1) == 2 ? Bv[2] : Bv[3], zero);
        f32x16 U = MFMA32(__builtin_bit_cast(bf16x8, cAk[0]), Bv[0], zero);
        U = MFMA32(__builtin_bit_cast(bf16x8, cAk[1]), Bv[1], U); U = MFMA32(__builtin_bit_cast(bf16x8, cAk[2]), Bv[2], U); U = MFMA32(__builtin_bit_cast(bf16x8, cAk[3]), Bv[3], U);
        if (!ML) {
            if ((w & 1) == 0) o0 = o0 + pi; else o1 = o1 + pi;
#pragma unroll
            for (int i = 0; i < 16; ++i) S[i] = cdec[i >> 2][i & 3] * (S[i] + U[i]);
        } else {
            const float blast = __shfl(csc, 0), cn = __shfl(csc, 1);
            const float il = cbb + m_prev, mt = fmaxf(il, cml);
            const float et = __expf(cml - mt), gt = __expf(il - mt);
            eg[lane] = et; eg[64 + lane] = gt;
            const float m_new = fmaxf(blast + m_prev, cn), decay = __expf(blast + m_prev - m_new), beta = __expf(cn - m_new);
            if (slice == 0) {
                if (w == 0) { float* dn = denS + (size_t)n * 192; dn[lane] = et; dn[64 + lane] = gt; dn[128 + lane] = __expf(-mt); }
                if (hh == 0) { nprevS[(size_t)n * 256] = nreg; nreg = decay * nreg + beta * cks; }
            }
            asm volatile("s_waitcnt lgkmcnt(0)" ::: "memory");
#pragma unroll
            for (int g = 0; g < 4; ++g) { const f32x4 g0 = *(const LAS f32x4*)(eg + 64 + 8 * g + 4 * hh), g1 = *(const LAS f32x4*)(eg + 64 + 32 + 8 * g + 4 * hh);
                const f32x4 e0 = *(const LAS f32x4*)(eg + 32 * (w & 1) + 8 * g + 4 * hh);
#pragma unroll
                for (int e = 0; e < 4; ++e) { o0[4 * g + e] *= g0[e]; o1[4 * g + e] *= g1[e];
                    if ((w & 1) == 0) o0[4 * g + e] += e0[e] * pi[4 * g + e]; else o1[4 * g + e] += e0[e] * pi[4 * g + e]; } }
#pragma unroll
            for (int i = 0; i < 16; ++i) S[i] = decay * S[i] + beta * U[i];
            m_prev = m_new;
        }
        { LAS unsigned char* img = lds + (n & 1) * 65536 + w * 8192 + c * 256;
#pragma unroll
          for (int g = 0; g < 4; ++g) { const int tq0 = 2 * g + hh, tq1 = 8 + 2 * g + hh;
              *(LAS f32x4*)(img + ((tq0 + c) & 15) * 16) = (f32x4){o0[4 * g], o0[4 * g + 1], o0[4 * g + 2], o0[4 * g + 3]};
              *(LAS f32x4*)(img + ((tq1 + c) & 15) * 16) = (f32x4){o1[4 * g], o1[4 * g + 1], o1[4 * g + 2], o1[4 * g + 3]}; } }
        if (more && tid < 256) *(LAS u32x4*)(vbuf + ((n + 1) & 1) * 4096 + tid * 16) = nv;
        __syncthreads();
        { const int tq = 2 * w + hh; f32x4 acc = {0.f, 0.f, 0.f, 0.f};
          const LAS unsigned char* img = lds + (n & 1) * 65536 + c * 256 + ((tq + c) & 15) * 16;
#pragma unroll
          for (int w2 = 0; w2 < 8; ++w2) acc = acc + *(const LAS f32x4*)(img + w2 * 8192);
          bf16_t* op = outp + (T0 + (size_t)n * 64 + 4 * tq) * 2048;
#pragma unroll
          for (int e = 0; e < 4; ++e) op[(size_t)e * 2048] = (bf16_t)f2bf(acc[e]); }
#pragma unroll
        for (int f = 0; f < 4; ++f) { cAq[f] = nAq[f]; cAk[f] = nAk[f]; }
        cPm = nPm;
        if (!ML) {
#pragma unroll
            for (int g = 0; g < 4; ++g) cdec[g] = ndec[g];
        } else { cbb = nbb; cml = nml; csc = nsc; cks = nks; }
    }
    __syncthreads();
}

DI void post_pass(const Frame& F, const Args& a) {
    unsigned char* ws = F.ws; const int lane = F.lane;
    const int gw = F.vcu * NWAVES + F.wave, NGW = F.G * NWAVES;
    const bf16_t* proj = (const bf16_t*)(ws + WS_PROJ); bf16_t* mixed = (bf16_t*)(ws + WS_MIXED);
    for (int task = gw; task < M * 8; task += NGW) {
        const int row = task >> 3, mh = task & 7, ml = mh >> 2, h = mh & 3;
        const u32x4 ov = *(const u32x4*)((const bf16_t*)(ws + (ml ? WS_OUTM : WS_OUTG)) + (size_t)row * 2048 + h * 512 + 8 * lane);
        float o[8] = {bflo(ov.x), bfhi(ov.x), bflo(ov.y), bfhi(ov.y), bflo(ov.z), bfhi(ov.z), bflo(ov.w), bfhi(ov.w)};
        const u32x4 gv = *(const u32x4*)(proj + (size_t)row * NPROJ + (ml ? C_OM : C_GG) + h * 512 + 8 * lane);
        const float gt[8] = {bflo(gv.x), bfhi(gv.x), bflo(gv.y), bfhi(gv.y), bflo(gv.z), bfhi(gv.z), bflo(gv.w), bfhi(gv.w)};
        const float* ng = a.in[ml ? IN_MNORM : IN_GNORM] + h * 512 + 8 * lane;
        const f32x4 n0 = *(const f32x4*)ng, n1 = *(const f32x4*)(ng + 4);
        const float nw[8] = {n0[0], n0[1], n0[2], n0[3], n1[0], n1[1], n1[2], n1[3]};
        if (ml) {
            const int b = row >> 13, tl = row & (SEQ - 1), n = tl >> 6, tt = tl & 63, sl = b * 4 + h;
            const float* dn = (const float*)(ws + WS_DENAUX) + ((size_t)sl * NCH + n) * 192;
            const float Ee = vloadf(dn + tt), Gg = vloadf(dn + 64 + tt), Xx = vloadf(dn + 128 + tt);
            const float rr = vloadf((const float*)(ws + WS_MST) + ((size_t)sl * NCH + n) * 256 + 128 + tt);
            float part = 0.f;
            if (lane < 32) { const int w = lane >> 2, ks = (lane >> 1) & 1, hh = lane & 1, tb = tt >> 5, r = tt & 31;
                const u32x4 qv = *((const u32x4*)(ws + WS_AQM) + ((size_t)sl * NCH + n) * 2048 + w * 256 + (tb * 2 + ks) * 64 + r + 32 * hh);
                const float* np = (const float*)(ws + WS_NPREV) + ((size_t)sl * NCH + n) * 256 + 32 * w + 16 * ks + 4 * hh;
                const f32x4 na = *(const f32x4*)np, nb = *(const f32x4*)(np + 8);
                part = bflo(qv.x) * na[0] + bfhi(qv.x) * na[1] + bflo(qv.y) * na[2] + bfhi(qv.y) * na[3] + bflo(qv.z) * nb[0] + bfhi(qv.z) * nb[1] + bflo(qv.w) * nb[2] + bfhi(qv.w) * nb[3]; }
            const float qn = wave_sum(part);
            const float den = Ee * rr + Gg * qn, inv = 1.f / fmaxf(fabsf(den), Xx);
#pragma unroll
            for (int j = 0; j < 8; ++j) o[j] *= inv;
        }
        float ss = 0.f;
#pragma unroll
        for (int j = 0; j < 8; ++j) ss += o[j] * o[j];
        const float rn = __builtin_amdgcn_rsqf(wave_sum(ss) * (1.f / 512.f) + EPS);
        float y[8];
#pragma unroll
        for (int j = 0; j < 8; ++j) y[j] = o[j] * rn * nw[j] * (ml ? sigmoidf_(gt[j]) : siluf_(gt[j]));
        u32x4 wv; wv.x = pk2(y[0], y[1]); wv.y = pk2(y[2], y[3]); wv.z = pk2(y[4], y[5]); wv.w = pk2(y[6], y[7]);
        *(u32x4*)(mixed + (size_t)row * D + ml * 2048 + h * 512 + 8 * lane) = wv;
    }
}

DI void final_norm(const Frame& F, const Args& a) {
    const int gw = F.vcu * NWAVES + F.wave, NGW = F.G * NWAVES, lane = F.lane;
    const float* ss3 = (const float*)(F.ws + WS_SS3); const float* g = a.in[IN_NFING];
    for (int row = gw; row < M; row += NGW) {
        const float rstd = __builtin_amdgcn_rsqf(wave_sum(ss3[(size_t)row * 64 + lane]) * (1.f / D) + EPS);
        f32x4* p = (f32x4*)(a.out + (size_t)row * D) + lane;
#pragma unroll
        for (int j = 0; j < 16; ++j) { const f32x4 gv = *((const f32x4*)g + lane + 64 * j); p[64 * j] = p[64 * j] * rstd * gv; }
    }
}

struct SchedStd {
    int nM, nN, G, c, lda, ldb; size_t a0, b0, bbatch;
    DI bool next(int i, pg8::Unit& u) const { int pm, pn; if (!pg8::static_tile(i, G, c, nM, nN, pm, pn)) return false;
        u.pm = pm; u.pn = pn; u.z = 0; u.ldc = 0; u.coff = 0; u.aoff = a0 + (size_t)pm * 256 * lda; u.boff = b0 + (size_t)(pm >> 5) * bbatch + (size_t)pn * 256 * ldb; return true; }
};
struct SchedG1 : SchedStd {
    DI bool next(int i, pg8::Unit& u) const { if (!SchedStd::next(i, u)) return false; u.ldc = NPROJ; u.coff = WS_PROJ / 2 + (size_t)u.pm * 256 * NPROJ + (size_t)u.pn * 256; return true; }
};
struct SchedKV {
    int G, c;
    DI bool next(int i, pg8::Unit& u) const { const int L = i * G + c; if (L >= 64) return false; const int which = L >> 5, pm = (L >> 4) & 1, pn = L & 15;
        u.pm = pm; u.pn = pn; u.z = which; u.ldc = D; u.aoff = WS_MEMN / 2 + (size_t)pm * 256 * D; u.boff = (which ? WS_WV : WS_WK) / 2 + (size_t)pn * 256 * D;
        u.coff = (which ? WS_VB : WS_KB) / 2 + (size_t)pm * 256 * D + (size_t)pn * 256; return true; }
};
struct SchedX {
    int G, c;
    DI bool next(int i, pg8::Unit& u) const { const int L = i * G + c; if (L >= 256) return false; const int Lq = L & 127, b = Lq >> 6, h = (Lq >> 4) & 3, p = Lq & 15;
        u.z = L >> 7;
        if (L < 128) { u.pm = 0; u.pn = p; u.ldc = D; u.aoff = WS_KB / 2 + (size_t)b * 256 * D + h * 1024; u.boff = WS_WQ / 2 + (size_t)p * 256 * D + h * 1024;
            u.coff = WS_WQK / 2 + ((size_t)b * 1024 + h * 256) * D + (size_t)p * 256; }
        else { u.pm = 0; u.pn = 0; u.ldc = 1024; u.aoff = WS_WO / 2 + (size_t)p * 256 * D + h * 1024; u.boff = WS_VB / 2 + (size_t)b * 256 * D + h * 1024;
            u.coff = WS_VW / 2 + ((size_t)b * D + (size_t)p * 256) * 1024 + h * 256; }
        return true; }
};
struct SchedScore {
    int vcu;
    DI bool next(int i, pg8::Unit& u) const { if (i > 0 || vcu >= 256) return false; const int pm = vcu >> 2, hd = vcu & 3;
        u.pm = pm; u.pn = hd; u.z = 0; u.ldc = 1024; u.coff = 0; u.aoff = WS_HB / 2 + (size_t)pm * 256 * D; u.boff = WS_WQK / 2 + ((size_t)(pm >> 5) * 1024 + hd * 256) * D; return true; }
};

__global__ void __launch_bounds__(NWAVES * 64, 2) fwd_kernel(Args args) {
    extern __shared__ __attribute__((aligned(16))) unsigned char lds_raw[];
    Frame F;
    F.lds = (LAS unsigned char*)lds_raw; F.ws = args.ws;
    F.tid = threadIdx.x; F.lane = F.tid & 63; F.wave = __builtin_amdgcn_readfirstlane(F.tid >> 6);
    F.G = gridDim.x; F.bx = blockIdx.x; F.vcu = (F.G % 8 == 0) ? (F.bx % 8) * (F.G / 8) + F.bx / 8 : F.bx;
    volatile LAS unsigned* MISC = (volatile LAS unsigned*)(F.lds + MISC_OFF);
    for (int u = F.tid; u < (LDS_BYTES - LDSCTL_OFF) / 4; u += NWAVES * 64) ((LAS unsigned*)(F.lds + LDSCTL_OFF))[u] = 0u;
    __syncthreads();
    gu32* ctl = (gu32*)(args.ws + WS_CTL);
    XcdBarrier bar = xcd_barrier_post((unsigned*)(ctl + CW_BAR), MISC + 8);
    const int lo = args.ph_lo, hi = args.ph_hi;
#define IN(k) (lo <= (k) && (k) < hi)
#define SEAM(k) do { if (IN(k) && IN((k) + 1)) xcd_barrier(bar); } while (0)
    const bf16_t* wsb = (const bf16_t*)args.ws;
    float* ss1 = (float*)(args.ws + WS_SS1); float* ss2 = (float*)(args.ws + WS_SS2); float* ss3 = (float*)(args.ws + WS_SS3);

    if (IN(0)) { p0a_weights(F, args); } SEAM(0);
    if (IN(1)) { p0b_x(F, args); } SEAM(1);
    if (IN(2)) {
        pg8::Gemm g{wsb, D, D, D}; SchedKV S{F.G, F.bx}; pg8::EpiBf16 E{(bf16_t*)args.ws, nullptr};
        pg8::gemm_phase<pg8::EpiBf16, SchedKV, true>(F.lds, g, S, E);
    } SEAM(2);
    if (IN(3)) {
        pg8::Gemm g{wsb, D, D, D}; SchedG1 S; S.nM = 64; S.nN = 48; S.G = F.G; S.c = F.bx; S.lda = D; S.ldb = D; S.a0 = WS_XB / 2; S.b0 = WS_WIN / 2; S.bbatch = 0;
        pg8::EpiBf16 E{(bf16_t*)args.ws, (const float*)(args.ws + WS_RSTD0)};
        pg8::gemm_phase<pg8::EpiBf16, SchedG1, true>(F.lds, g, S, E);
    } SEAM(3);
    if (IN(4)) {
        pg8::Gemm g{wsb, D, D, 1024}; SchedX S{F.G, F.bx}; pg8::EpiBf16 E{(bf16_t*)args.ws, nullptr};
        pg8::gemm_phase<pg8::EpiBf16, SchedX, true>(F.lds, g, S, E);
    } SEAM(4);
    if (IN(5)) {
        for (int it = F.vcu; it < 2048; it += F.G) { const int s = it >> 7, n = it & 127; if (s < 8) pre_item<false>(F, args, s, n); else pre_item<true>(F, args, s, n); }
    } SEAM(5);
    if (IN(6)) {
        if (F.vcu < 256) { const int s = F.vcu >> 4, slice = F.vcu & 15; if (s < 8) scan_stream<false>(F, args, s, slice); else scan_stream<true>(F, args, s, slice); }
    } SEAM(6);
    if (IN(7)) { post_pass(F, args); } SEAM(7);
    if (IN(8)) {
        pg8::Gemm g{wsb, D, D, D}; SchedStd S{64, 16, F.G, F.bx, D, D, WS_MIXED / 2, WS_WOUT / 2, 0};
        pg8::EpiResid E{args.in[IN_X], args.out, (bf16_t*)(args.ws + WS_HB), ss1};
        pg8::gemm_phase<pg8::EpiResid, SchedStd, true>(F.lds, g, S, E);
    } SEAM(8);
    if (IN(9)) {
        pg8::Gemm g{wsb, D, D, D}; SchedScore S{F.vcu}; pg8::EpiSoftmax E{(bf16_t*)(args.ws + WS_P), ss1};
        pg8::gemm_phase<pg8::EpiSoftmax, SchedScore, false>(F.lds, g, S, E);
    } SEAM(9);
    if (IN(10)) {
        pg8::Gemm g{wsb, 1024, 1024, 1024}; SchedStd S{64, 16, F.G, F.bx, 1024, 1024, WS_P / 2, WS_VW / 2, (size_t)D * 1024};
        pg8::EpiResid E{args.out, args.out, (bf16_t*)(args.ws + WS_HB), ss2};
        pg8::gemm_phase<pg8::EpiResid, SchedStd, true>(F.lds, g, S, E);
    } SEAM(10);
    if (IN(11)) {
        pg8::Gemm g{wsb, D, D, D}; SchedStd S{64, 86, F.G, F.bx, D, D, WS_HB / 2, WS_WGU / 2, 0};
        pg8::EpiSwiglu E{(bf16_t*)(args.ws + WS_ACT), ss2};
        pg8::gemm_phase<pg8::EpiSwiglu, SchedStd, true>(F.lds, g, S, E);
    } SEAM(11);
    if (IN(12)) {
        pg8::Gemm g{wsb, FF, FF, FF}; SchedStd S{64, 16, F.G, F.bx, FF, FF, WS_ACT / 2, WS_WDN / 2, 0};
        pg8::EpiResid E{args.out, args.out, nullptr, ss3};
        pg8::gemm_phase<pg8::EpiResid, SchedStd, true>(F.lds, g, S, E);
    } SEAM(12);
    if (IN(13)) { final_norm(F, args); }
#undef IN
#undef SEAM
}

#ifndef MK_PER_PHASE
#define MK_PER_PHASE 0
#endif
constexpr int NPHASES = 14;
extern "C" void kernel_launch(void* const* d_in, const int* in_sizes, int n_in, void* d_out, int out_size, void* d_ws, size_t ws_size, hipStream_t stream) {
    static int grid = 0;
    if (grid == 0) {
        if (n_in != 24 || in_sizes[0] != M * D || out_size != M * D || ws_size < WS_END) {
            fprintf(stderr, "kernel_launch: unexpected problem (n_in %d, in0 %d, out %d, ws %zu < %zu); nothing launched\n", n_in, n_in > 0 ? in_sizes[0] : -1, out_size, ws_size, (size_t)WS_END); grid = -1; return; }
        int dev = 0, cus = 0, per_cu = 0;
        if (hipGetDevice(&dev) != hipSuccess || hipDeviceGetAttribute(&cus, hipDeviceAttributeMultiprocessorCount, dev) != hipSuccess) { grid = -1; return; }
        if (hipFuncSetAttribute((const void*)fwd_kernel, hipFuncAttributeMaxDynamicSharedMemorySize, LDS_BYTES) != hipSuccess) { fprintf(stderr, "kernel_launch: hipFuncSetAttribute failed\n"); grid = -1; return; }
        if (hipOccupancyMaxActiveBlocksPerMultiprocessor(&per_cu, (const void*)fwd_kernel, NWAVES * 64, LDS_BYTES) != hipSuccess || per_cu < 1)
            fprintf(stderr, "kernel_launch: occupancy query reports %d workgroups per CU\n", per_cu);
        (void)hipGetLastError();
        grid = cus < 256 ? cus : 256;
        if (grid != 256) fprintf(stderr, "kernel_launch: %d CUs; this kernel is built for 256\n", cus);
    }
    if (grid < 0) return;
    if (hipMemsetAsync((char*)d_ws + WS_CTL, 0, CTL_ZERO_BYTES, stream) != hipSuccess) return;
    Args a{};
    for (int i = 0; i < 24; ++i) a.in[i] = (const float*)d_in[i];
    a.out = (float*)d_out; a.ws = (unsigned char*)d_ws;
#if MK_PER_PHASE
    for (int p = 0; p < NPHASES; ++p) { a.ph_lo = p; a.ph_hi = p + 1; hipLaunchKernelGGL(fwd_kernel, dim3(grid), dim3(NWAVES * 64), LDS_BYTES, stream, a); }
#else
    a.ph_lo = 0; a.ph_hi = NPHASES;
    hipLaunchKernelGGL(fwd_kernel, dim3(grid), dim3(NWAVES * 64), LDS_BYTES, stream, a);
#endif
    const hipError_t le = hipPeekAtLastError();
    if (le != hipSuccess) fprintf(stderr, "kernel_launch: launch failed: %s\n", hipGetErrorName(le));
}
```

```cpp
#include <hip/hip_runtime.h>
#include <cstdio>
#include <cstdint>

#define LAS __attribute__((address_space(3)))
#define GAS __attribute__((address_space(1)))
typedef unsigned short bf16_t;
typedef short bf16x8 __attribute__((ext_vector_type(8)));
typedef float f32x4 __attribute__((ext_vector_type(4)));
typedef float f32x2 __attribute__((ext_vector_type(2)));
typedef float f32x16 __attribute__((ext_vector_type(16)));
typedef unsigned u32x4 __attribute__((ext_vector_type(4)));
typedef unsigned u32x2 __attribute__((ext_vector_type(2)));
typedef GAS unsigned gu32;
#define RLX_AGENT __ATOMIC_RELAXED, __HIP_MEMORY_SCOPE_AGENT
#define DI __device__ __forceinline__

constexpr int D = 4096, SEQ = 8192, M = 16384, NPROJ = 12288, INCOLS = 12312, FF = 11008, NCH = 128;
constexpr float EPS = 1e-6f;
constexpr int C_QG = 0, C_KG = 1024, C_VG = 2048, C_GG = 4096, C_QM = 6144, C_KM = 7168, C_VM = 8192, C_OM = 10240;

constexpr size_t MiB = 1u << 20;
constexpr size_t WS_CTL = 0, CTL_ZERO_BYTES = 1 * MiB;
constexpr size_t WS_RSTD0 = 1 * MiB;
constexpr size_t WS_SMALLP = 2 * MiB;
constexpr size_t WS_SS1 = 4 * MiB, WS_SS2 = 8 * MiB, WS_SS3 = 12 * MiB;
constexpr size_t WS_WSMALL = 16 * MiB;
constexpr size_t WS_MEMN = 17 * MiB;
constexpr size_t WS_KB = 24 * MiB, WS_VB = 28 * MiB;
constexpr size_t WS_WQK = 32 * MiB;
constexpr size_t WS_VW = 48 * MiB;
constexpr size_t WS_WOUT = 64 * MiB, WS_WQ = 96 * MiB, WS_WK = 128 * MiB, WS_WV = 160 * MiB, WS_WO = 192 * MiB;
constexpr size_t WS_WGU = 224 * MiB;
constexpr size_t WS_WDN = 396 * MiB;
constexpr size_t WS_WIN = 482 * MiB;
constexpr size_t WS_XB = 578 * MiB;
constexpr size_t WS_DEC = 482 * MiB;
constexpr size_t WS_KSUM = 484 * MiB;
constexpr size_t WS_NPREV = 485 * MiB;
constexpr size_t WS_EGX = 21 * MiB;
constexpr size_t WS_RP = 483 * MiB;
constexpr size_t WS_DB = 22 * MiB;
constexpr size_t WS_AQM = 490 * MiB, WS_AQG = 522 * MiB, WS_AKG = 554 * MiB, WS_AKM = 586 * MiB;
constexpr size_t WS_PMG = 618 * MiB, WS_PMM = 626 * MiB;
constexpr size_t WS_MIXED = 522 * MiB;
constexpr size_t WS_P = 650 * MiB;
constexpr size_t WS_PROJ = 706 * MiB;
constexpr size_t WS_ACT = 706 * MiB;
constexpr size_t WS_OUTG = 1090 * MiB, WS_OUTM = 1154 * MiB;
constexpr size_t WS_HB = 1090 * MiB;
constexpr size_t WS_END = 1218 * MiB;

constexpr int CW_TMO = 0, CW_CODE = 1, CW_BAR = 4096;

constexpr int RING_BYTES = 131072;
constexpr int LDS_X0 = RING_BYTES;
constexpr int LDS_X1 = RING_BYTES + 16384;
constexpr int LDSCTL_OFF = RING_BYTES + 20480, MISC_OFF = LDSCTL_OFF + 64;
constexpr int LDS_BYTES = 155648;
constexpr int NWAVES = 8;

typedef __bf16 bf16x2_t __attribute__((ext_vector_type(2)));
DI unsigned cvt_pk_bf16(float lo, float hi) { const f32x2 v = {lo, hi}; return __builtin_bit_cast(unsigned, __builtin_convertvector(v, bf16x2_t)); }
DI unsigned f2bf(float f) { return (unsigned)__builtin_bit_cast(unsigned short, (__bf16)f); }
DI unsigned pk2(float lo, float hi) { return cvt_pk_bf16(lo, hi); }
DI float bf2f(unsigned short b) { return __builtin_bit_cast(float, ((unsigned)b) << 16); }
DI float bflo(unsigned w) { return __builtin_bit_cast(float, w << 16); }
DI float bfhi(unsigned w) { return __builtin_bit_cast(float, w & 0xffff0000u); }
DI float wave_sum(float v) {
#pragma unroll
    for (int o = 1; o < 64; o <<= 1) v += __shfl_xor(v, o);
    return v;
}
DI float logsigmoidf(float x) { return fminf(x, 0.f) - __logf(1.f + __expf(-fabsf(x))); }
DI float sigmoidf_(float x) { return 1.f / (1.f + __expf(-x)); }
DI float siluf_(float x) { return x / (1.f + __expf(-x)); }
DI float vloadf(const float* p) { return __builtin_bit_cast(float, __hip_atomic_load((const unsigned*)p, RLX_AGENT)); }

namespace pg8 {
constexpr int BM = 256, BK = 64, HALF = 128, HTB = HALF * BK * 2, STAGE_BYTES = 8 * HTB, NXCD = 8, WGM = 8;
__host__ __device__ __forceinline__ int lds_byte(int r, int c) { const int st = (r >> 4) * 2 + (c >> 5), rr = r & 15, cc = c & 31, ob = rr * 64 + cc * 2; return st * 1024 + (ob ^ (((ob >> 9) & 1) << 5)); }
__host__ __device__ __forceinline__ void stage_rc(int b, int& R, int& C) { const int st = b / 1024, sb = b % 1024, swz = sb ^ (((sb >> 9) & 1) << 5); R = (st >> 1) * 16 + swz / 64; C = (st & 1) * 32 + (swz % 64) / 2; }
__host__ __device__ __forceinline__ int perm32(int rho) { const int n = rho >> 4, i = rho & 15; return 8 * (i >> 2) + 4 * n + (i & 3); }

struct Unit { int pm, pn, ldc, z; size_t aoff, boff, coff; };
struct Gemm { const bf16_t* base; int lda, ldb, K; };

DI bool static_tile(int i, int G, int c, int nM, int nN, int& pm, int& pn) {
    const int nwg = nM * nN; const long L = (long)i * G + c; if (L >= nwg) return false;
    int wgid = (int)L; { const int q = nwg / NXCD, r = nwg % NXCD, xcd = wgid % NXCD, off = wgid / NXCD; wgid = (xcd < r ? xcd * (q + 1) : r * (q + 1) + (xcd - r) * q) + off; }
    const int nig = WGM * nN, gid = wgid / nig, fm = gid * WGM, gsz = (nM - fm) < WGM ? (nM - fm) : WGM;
    pm = fm + ((wgid % nig) % gsz); pn = (wgid % nig) / gsz; return true;
}
#ifndef PG8_SP2
#define PG8_SP2 true
#endif
template <class Epi, class Sched, bool ALIGN_EPI, bool SP2 = PG8_SP2>
DI void gemm_phase(LAS unsigned char* lds, const Gemm g, const Sched& S, const Epi& E) {
    const int tid = threadIdx.x, wid = __builtin_amdgcn_readfirstlane(tid >> 6), lane = tid & 63, wr = wid >> 2, wc = wid & 3, fr = lane & 15, fq = lane >> 4;
    const int K = g.K, nt = K / BK;
    unsigned voffA[2], voffB[2];
#pragma unroll
    for (int i = 0; i < 2; ++i) { int R, C; stage_rc(tid * 16 + i * 8192, R, C); const int Rb = (R & ~31) + perm32(R & 31);
        voffA[i] = (unsigned)(R * g.lda + C) * 2u; voffB[i] = (unsigned)(Rb * g.ldb + C) * 2u; }
    const size_t kstep = (size_t)(BK * 2);
    const size_t hstepA = (size_t)HALF * g.lda * 2, hstepB = (size_t)HALF * g.ldb * 2;
    const unsigned ldsw = (unsigned)wid * 1024u;
    const int aoff = lds_byte(wr * 64 + fr, fq * 8), boff = lds_byte(wc * 32 + fr, fq * 8);
#define PG8_SA(b, h) (((b) * 2 + (h)) * HTB)
#define PG8_SB(b, h) ((4 + (b) * 2 + (h)) * HTB)
#define PG8_STAGE(bufoff, gbase, voff) do { _Pragma("unroll") for (int _i = 0; _i < 2; ++_i) \
        __builtin_amdgcn_global_load_lds((const unsigned*)((const char*)(gbase) + (voff)[_i]), (LAS unsigned*)(lds + (bufoff) + ldsw + _i * 8192), 16, 0, 0); } while (0)
#define PG8_LDA(dst, b, h) do { _Pragma("unroll") for (int m = 0; m < 4; ++m) _Pragma("unroll") for (int k = 0; k < 2; ++k) dst[m][k] = *(const LAS bf16x8*)(lds + PG8_SA(b, h) + aoff + m * 2048 + k * 1024); } while (0)
#define PG8_LDB(dst, b, h) do { _Pragma("unroll") for (int n = 0; n < 2; ++n) _Pragma("unroll") for (int k = 0; k < 2; ++k) dst[n][k] = *(const LAS bf16x8*)(lds + PG8_SB(b, h) + boff + n * 2048 + k * 1024); } while (0)
#define PG8_MMA(ai, bj, At, Bt) do { __builtin_amdgcn_s_setprio(1); _Pragma("unroll") for (int m = 0; m < 4; ++m) _Pragma("unroll") for (int n = 0; n < 2; ++n) _Pragma("unroll") for (int k = 0; k < 2; ++k) \
        acc[ai][bj][m][n] = __builtin_amdgcn_mfma_f32_16x16x32_bf16(Bt[n][k], At[m][k], acc[ai][bj][m][n], 0, 0, 0); __builtin_amdgcn_s_setprio(0); } while (0)
#define PG8_WAIT_V(n) asm volatile("s_waitcnt vmcnt(" #n ")" ::: "memory")
#define PG8_WAIT_L(n) asm volatile("s_waitcnt lgkmcnt(" #n ")" ::: "memory")
#define PG8_BAR __builtin_amdgcn_s_barrier()
#define PG8_SCHED __builtin_amdgcn_sched_barrier(0)
    Unit cur, nxt; int ui = 0;
    if (!S.next(0, cur)) return;
    f32x4 acc[2][2][4][2];
#pragma unroll
    for (int a = 0; a < 2; ++a)
#pragma unroll
        for (int b = 0; b < 2; ++b)
#pragma unroll
            for (int m = 0; m < 4; ++m)
#pragma unroll
                for (int n = 0; n < 2; ++n) acc[a][b][m][n] = (f32x4){0.f, 0.f, 0.f, 0.f};
    bf16x8 At[4][2], B0[2][2], B1[2][2];
    const char* cA = (const char*)(g.base + cur.aoff); const char* cB = (const char*)(g.base + cur.boff);
    if constexpr (SP2) {
    PG8_STAGE(PG8_SB(0, 0), cB, voffB); PG8_STAGE(PG8_SB(0, 1), cB + hstepB, voffB); PG8_STAGE(PG8_SA(0, 0), cA, voffA); PG8_STAGE(PG8_SA(0, 1), cA + hstepA, voffA);
    if (wr == 1) PG8_BAR;
    PG8_WAIT_V(2); PG8_BAR;
    PG8_STAGE(PG8_SB(1, 0), cB + kstep, voffB); PG8_STAGE(PG8_SA(1, 0), cA + kstep, voffA); PG8_STAGE(PG8_SB(1, 1), cB + hstepB + kstep, voffB);
    PG8_WAIT_V(6); PG8_BAR;
    } else {
    PG8_STAGE(PG8_SB(0, 0), cB, voffB); PG8_STAGE(PG8_SA(0, 0), cA, voffA); PG8_STAGE(PG8_SB(0, 1), cB + hstepB, voffB); PG8_STAGE(PG8_SA(0, 1), cA + hstepA, voffA);
    if (wr == 1) PG8_BAR;
    PG8_WAIT_V(4); PG8_BAR;
    PG8_STAGE(PG8_SB(1, 0), cB + kstep, voffB); PG8_STAGE(PG8_SA(1, 0), cA + kstep, voffA); PG8_STAGE(PG8_SB(1, 1), cB + hstepB + kstep, voffB);
    PG8_WAIT_V(6); PG8_BAR;
    }
    for (;;) {
        const bool has_next = S.next(ui + 1, nxt);
        const char* nA = has_next ? (const char*)(g.base + nxt.aoff) : cA; const char* nB = has_next ? (const char*)(g.base + nxt.boff) : cB;
        for (int t = 0; t < nt; t += 2) {
            const bool last = (t == nt - 2);
            const char* a1 = cA + (size_t)(t + 1) * kstep;
            const char* a2 = last ? nA : cA + (size_t)(t + 2) * kstep; const char* b2 = last ? nB : cB + (size_t)(t + 2) * kstep;
            const char* a3 = a2 + kstep; const char* b3 = b2 + kstep;
            if constexpr (SP2) {
            PG8_LDB(B0, 0, 0); PG8_LDB(B1, 0, 1); PG8_SCHED; PG8_LDA(At, 0, 0); PG8_STAGE(PG8_SA(1, 1), a1 + hstepA, voffA);
            PG8_WAIT_V(8); PG8_WAIT_L(0); PG8_BAR; PG8_MMA(0, 0, At, B0); PG8_MMA(0, 1, At, B1); PG8_BAR; PG8_SCHED;
            PG8_LDA(At, 0, 1); PG8_STAGE(PG8_SB(0, 0), b2, voffB); PG8_STAGE(PG8_SB(0, 1), b2 + hstepB, voffB); PG8_STAGE(PG8_SA(0, 0), a2, voffA);
            PG8_WAIT_V(8); PG8_WAIT_L(0); PG8_BAR; PG8_MMA(1, 0, At, B0); PG8_MMA(1, 1, At, B1); PG8_BAR; PG8_SCHED;
            PG8_LDB(B0, 1, 0); PG8_LDB(B1, 1, 1); PG8_SCHED; PG8_LDA(At, 1, 0); PG8_STAGE(PG8_SA(0, 1), a2 + hstepA, voffA);
            PG8_WAIT_V(8); PG8_WAIT_L(0); PG8_BAR; PG8_MMA(0, 0, At, B0); PG8_MMA(0, 1, At, B1); PG8_BAR; PG8_SCHED;
            PG8_LDA(At, 1, 1); PG8_STAGE(PG8_SB(1, 0), b3, voffB); PG8_STAGE(PG8_SB(1, 1), b3 + hstepB, voffB); PG8_STAGE(PG8_SA(1, 0), a3, voffA);
            PG8_WAIT_V(8); PG8_WAIT_L(0); PG8_BAR; PG8_MMA(1, 0, At, B0); PG8_MMA(1, 1, At, B1); PG8_BAR; PG8_SCHED;
            } else {
            PG8_LDB(B0, 0, 0); PG8_SCHED; PG8_LDA(At, 0, 0); PG8_STAGE(PG8_SA(1, 1), a1 + hstepA, voffA);
            PG8_WAIT_L(8); PG8_BAR; PG8_WAIT_L(0); PG8_MMA(0, 0, At, B0); PG8_BAR; PG8_SCHED;
            PG8_LDB(B1, 0, 1); PG8_STAGE(PG8_SB(0, 0), b2, voffB);
            PG8_BAR; PG8_WAIT_L(0); PG8_MMA(0, 1, At, B1); PG8_BAR;
            PG8_LDA(At, 0, 1); PG8_STAGE(PG8_SA(0, 0), a2, voffA);
            PG8_BAR; PG8_WAIT_L(0); PG8_MMA(1, 0, At, B0); PG8_BAR; PG8_SCHED;
            PG8_STAGE(PG8_SB(0, 1), b2 + hstepB, voffB);
            PG8_WAIT_V(6); PG8_BAR; PG8_MMA(1, 1, At, B1); PG8_BAR;
            PG8_LDB(B0, 1, 0); PG8_SCHED; PG8_LDA(At, 1, 0); PG8_STAGE(PG8_SA(0, 1), a2 + hstepA, voffA);
            PG8_WAIT_L(8); PG8_BAR; PG8_WAIT_L(0); PG8_MMA(0, 0, At, B0); PG8_BAR; PG8_SCHED;
            PG8_LDB(B1, 1, 1); PG8_STAGE(PG8_SB(1, 0), b3, voffB);
            PG8_BAR; PG8_WAIT_L(0); PG8_MMA(0, 1, At, B1); PG8_BAR;
            PG8_LDA(At, 1, 1); PG8_STAGE(PG8_SA(1, 0), a3, voffA);
            PG8_BAR; PG8_WAIT_L(0); PG8_MMA(1, 0, At, B0); PG8_BAR; PG8_SCHED;
            PG8_STAGE(PG8_SB(1, 1), b3 + hstepB, voffB);
            PG8_WAIT_V(6); PG8_BAR; PG8_MMA(1, 1, At, B1); PG8_BAR;
            }
        }
        if constexpr (ALIGN_EPI) { if (wr == 0) PG8_BAR; }
        if constexpr (!Epi::AFTER_DRAIN) { E(acc, cur, wr, wc, fr, fq); }
        if (!has_next) break;
#pragma unroll
        for (int a = 0; a < 2; ++a)
#pragma unroll
            for (int b = 0; b < 2; ++b)
#pragma unroll
                for (int m = 0; m < 4; ++m)
#pragma unroll
                    for (int n = 0; n < 2; ++n) acc[a][b][m][n] = (f32x4){0.f, 0.f, 0.f, 0.f};
        cur = nxt; cA = nA; cB = nB; ++ui;
        if constexpr (ALIGN_EPI) { if (wr == 1) PG8_BAR; }
    }
    PG8_WAIT_V(0);
    if constexpr (!ALIGN_EPI) { if (wr == 0) PG8_BAR; }
    PG8_BAR;
    if constexpr (Epi::AFTER_DRAIN) { E.fused(acc, cur, wr, wc, fr, fq, lds, wid, lane); }
#undef PG8_SA
#undef PG8_SB
#undef PG8_STAGE
#undef PG8_LDA
#undef PG8_LDB
#undef PG8_MMA
#undef PG8_WAIT_V
#undef PG8_WAIT_L
#undef PG8_BAR
#undef PG8_SCHED
}

DI void rstd_from_parts(const float* ss, int row0, int fq, float (&rs)[2][4]) {
#pragma unroll
    for (int ai = 0; ai < 2; ++ai)
#pragma unroll
        for (int m = 0; m < 4; ++m) {
            const f32x4* p = (const f32x4*)(ss + (size_t)(row0 + ai * HALF + m * 16) * 64 + fq * 16);
            const f32x4 a = p[0], b = p[1], c = p[2], d = p[3];
            float s = ((a[0] + a[1]) + (a[2] + a[3])) + ((b[0] + b[1]) + (b[2] + b[3])) + ((c[0] + c[1]) + (c[2] + c[3])) + ((d[0] + d[1]) + (d[2] + d[3]));
            s += __shfl_xor(s, 16); s += __shfl_xor(s, 32);
            rs[ai][m] = __builtin_amdgcn_rsqf(s * (1.0f / D) + EPS);
        }
}
struct EpiBf16 {
    static constexpr bool AFTER_DRAIN = false;
    bf16_t* base; const LAS float* rstd; const float* rstd_g;
    DI void operator()(const f32x4 (&acc)[2][2][4][2], const Unit& u, int wr, int wc, int fr, int fq) const {
        const int lrow = wr * 64 + fr, lcol = wc * 32 + 8 * fq;
#pragma unroll
        for (int ai = 0; ai < 2; ++ai)
#pragma unroll
            for (int m = 0; m < 4; ++m) { const int r = lrow + ai * HALF + m * 16; const float s = rstd ? rstd[r] : (rstd_g ? rstd_g[u.pm * BM + r] : 1.f);
                bf16_t* rowp = base + u.coff + (size_t)r * u.ldc + lcol;
#pragma unroll
                for (int bj = 0; bj < 2; ++bj) { const f32x4 v0 = acc[ai][bj][m][0] * s, v1 = acc[ai][bj][m][1] * s;
                    u32x4 w; w.x = cvt_pk_bf16(v0[0], v0[1]); w.y = cvt_pk_bf16(v0[2], v0[3]); w.z = cvt_pk_bf16(v1[0], v1[1]); w.w = cvt_pk_bf16(v1[2], v1[3]);
                    *(u32x4*)(rowp + bj * HALF) = w; } }
    }
};
template <bool RB16>
struct EpiResid {
    static constexpr bool AFTER_DRAIN = false;
    const void* resid; bf16_t* hb; float* sspart; float* out32;
    DI void operator()(const f32x4 (&acc)[2][2][4][2], const Unit& u, int wr, int wc, int fr, int fq) const {
        const int row0 = u.pm * BM + wr * 64 + fr, col0 = u.pn * BM + wc * 32 + 8 * fq;
#pragma unroll
        for (int ai = 0; ai < 2; ++ai) {
            u32x4 rb[4][2];
            if constexpr (RB16) {
#pragma unroll
                for (int m = 0; m < 4; ++m)
#pragma unroll
                    for (int bj = 0; bj < 2; ++bj) rb[m][bj] = *(const u32x4*)((const bf16_t*)resid + (size_t)(row0 + ai * HALF + m * 16) * D + col0 + bj * HALF);
            }
#pragma unroll
            for (int m = 0; m < 4; ++m) { const int row = row0 + ai * HALF + m * 16; const size_t off = (size_t)row * D + col0; float q = 0.f;
#pragma unroll
                for (int bj = 0; bj < 2; ++bj) { f32x4 r0, r1;
                    if constexpr (RB16) { const u32x4 w = rb[m][bj]; r0 = (f32x4){bflo(w.x), bfhi(w.x), bflo(w.y), bfhi(w.y)}; r1 = (f32x4){bflo(w.z), bfhi(w.z), bflo(w.w), bfhi(w.w)}; }
                    else { const float* rp = (const float*)resid + off + bj * HALF; r0 = *(const f32x4*)rp; r1 = *(const f32x4*)(rp + 4); }
                    const f32x4 h0 = r0 + acc[ai][bj][m][0], h1 = r1 + acc[ai][bj][m][1];
                    q += (h0[0] * h0[0] + h0[1] * h0[1]) + (h0[2] * h0[2] + h0[3] * h0[3]) + (h1[0] * h1[0] + h1[1] * h1[1]) + (h1[2] * h1[2] + h1[3] * h1[3]);
                    u32x4 w; w.x = cvt_pk_bf16(h0[0], h0[1]); w.y = cvt_pk_bf16(h0[2], h0[3]); w.z = cvt_pk_bf16(h1[0], h1[1]); w.w = cvt_pk_bf16(h1[2], h1[3]);
                    if (hb) *(u32x4*)(hb + off + bj * HALF) = w;
                    if (out32) { *(f32x4*)(out32 + off + bj * HALF) = h0; *(f32x4*)(out32 + off + bj * HALF + 4) = h1; } }
                q += __shfl_xor(q, 16); q += __shfl_xor(q, 32);
                if (fq == 0) sspart[(size_t)row * 64 + u.pn * 4 + wc] = q;
                if constexpr (!RB16) asm volatile("" ::: "memory"); }
        }
    }
};
struct EpiSwiglu {
    static constexpr bool AFTER_DRAIN = false;
    bf16_t* act; const LAS float* rstd_lds;
    DI void operator()(const f32x4 (&acc)[2][2][4][2], const Unit& u, int wr, int wc, int fr, int fq) const {
        const int row0 = u.pm * BM + wr * 64 + fr, col0 = u.pn * HALF + wc * 32 + 8 * fq;
        float rs[2][4];
#pragma unroll
        for (int ai = 0; ai < 2; ++ai)
#pragma unroll
            for (int m = 0; m < 4; ++m) rs[ai][m] = rstd_lds[wr * 64 + fr + ai * HALF + m * 16];
#pragma unroll
        for (int ai = 0; ai < 2; ++ai)
#pragma unroll
            for (int m = 0; m < 4; ++m) { const int row = row0 + ai * HALF + m * 16; const float r = rs[ai][m];
                float o[8];
#pragma unroll
                for (int n = 0; n < 2; ++n)
#pragma unroll
                    for (int e = 0; e < 4; ++e) { const float gt = acc[ai][0][m][n][e] * r, up = acc[ai][1][m][n][e] * r;
                        o[n * 4 + e] = gt * up * __builtin_amdgcn_rcpf(1.f + __expf(-gt)); }
                u32x4 w; w.x = cvt_pk_bf16(o[0], o[1]); w.y = cvt_pk_bf16(o[2], o[3]); w.z = cvt_pk_bf16(o[4], o[5]); w.w = cvt_pk_bf16(o[6], o[7]);
                *(u32x4*)(act + (size_t)row * FF + col0) = w; }
    }
};
struct EpiSoftmax {
    static constexpr bool AFTER_DRAIN = true;
    bf16_t* P; const float* sspart;
    DI void operator()(const f32x4 (&)[2][2][4][2], const Unit&, int, int, int, int) const {}
    DI void fused(f32x4 (&acc)[2][2][4][2], const Unit& u, int wr, int wc, int fr, int fq, LAS unsigned char* lds, int wid, int lane) const {
        const int lrow = wr * 64 + fr, row0 = u.pm * BM + lrow;
        float rs[2][4]; rstd_from_parts(sspart, row0, fq, rs);
        LAS f32x2* T = (LAS f32x2*)lds;
        float mw[2][4];
#pragma unroll
        for (int ai = 0; ai < 2; ++ai)
#pragma unroll
            for (int m = 0; m < 4; ++m) { const float sc = rs[ai][m] * (0.03125f * 1.4426950408889634f); float mx = -3.0e38f;
#pragma unroll
                for (int bj = 0; bj < 2; ++bj)
#pragma unroll
                    for (int n = 0; n < 2; ++n) { acc[ai][bj][m][n] = acc[ai][bj][m][n] * sc; const f32x4 x = acc[ai][bj][m][n]; mx = fmaxf(fmaxf(mx, fmaxf(x[0], x[1])), fmaxf(x[2], x[3])); }
                mx = fmaxf(mx, __shfl_xor(mx, 16)); mx = fmaxf(mx, __shfl_xor(mx, 32)); float l = 0.f;
#pragma unroll
                for (int bj = 0; bj < 2; ++bj)
#pragma unroll
                    for (int n = 0; n < 2; ++n) { f32x4 x = acc[ai][bj][m][n];
#pragma unroll
                        for (int e = 0; e < 4; ++e) { x[e] = __builtin_amdgcn_exp2f(x[e] - mx); l += x[e]; }
                        acc[ai][bj][m][n] = x; }
                l += __shfl_xor(l, 16); l += __shfl_xor(l, 32);
                mw[ai][m] = mx;
                if (fq == 0) T[(lrow + ai * HALF + m * 16) * 4 + wc] = (f32x2){mx, l}; }
        asm volatile("s_waitcnt lgkmcnt(0)" ::: "memory"); __builtin_amdgcn_s_barrier(); asm volatile("" ::: "memory");
        const int lcol = u.pn * BM + wc * 32 + 8 * fq;
#pragma unroll
        for (int ai = 0; ai < 2; ++ai)
#pragma unroll
            for (int m = 0; m < 4; ++m) { const int r = lrow + ai * HALF + m * 16;
                const f32x2 a = T[r * 4 + 0], b = T[r * 4 + 1], c = T[r * 4 + 2], d = T[r * 4 + 3];
                const float mx = fmaxf(fmaxf(a.x, b.x), fmaxf(c.x, d.x));
                const float L = a.y * __builtin_amdgcn_exp2f(a.x - mx) + b.y * __builtin_amdgcn_exp2f(b.x - mx) + c.y * __builtin_amdgcn_exp2f(c.x - mx) + d.y * __builtin_amdgcn_exp2f(d.x - mx);
                const float f = __builtin_amdgcn_exp2f(mw[ai][m] - mx) / L;
                bf16_t* rowp = P + (size_t)(u.pm * BM + r) * 1024 + lcol;
#pragma unroll
                for (int bj = 0; bj < 2; ++bj) { const f32x4 v0 = acc[ai][bj][m][0] * f, v1 = acc[ai][bj][m][1] * f;
                    u32x4 w; w.x = cvt_pk_bf16(v0[0], v0[1]); w.y = cvt_pk_bf16(v0[2], v0[3]); w.z = cvt_pk_bf16(v1[0], v1[1]); w.w = cvt_pk_bf16(v1[2], v1[3]);
                    *(u32x4*)(rowp + bj * HALF) = w; } }
    }
};
}

#define XB_TMO      128
#define XB_XCNT(j)  (256  + 64 * (j))
#define XB_XSUB(j)  (1280 + 64 * (j))
#define XB_XGEN(j)  (2304 + 64 * (j))
#define XB_TOP      3328
#define XB_TOPGEN   3392
#define XCD_BAR_WORDS 3456
#define XB_SPIN_CAP (1u << 18)
__device__ __forceinline__ unsigned xb_ld(unsigned* p)              { return __hip_atomic_load(p, __ATOMIC_RELAXED, __HIP_MEMORY_SCOPE_AGENT); }
__device__ __forceinline__ unsigned xb_add(unsigned* p, unsigned v) { return __hip_atomic_fetch_add(p, v, __ATOMIC_RELAXED, __HIP_MEMORY_SCOPE_AGENT); }
__device__ __forceinline__ unsigned xb_xcc_id() { return (unsigned)__builtin_amdgcn_s_getreg((3 << 11) | 20) & 0xFu; }
#define XB_SPIN(cond, bar) do { unsigned _sp = 0; while (cond) { __builtin_amdgcn_s_sleep(1); \
    if ((++_sp & 255u) == 0u) { if (xb_ld(&(bar)[XB_TMO])) break; if (_sp > XB_SPIN_CAP) { atomicAdd(&(bar)[XB_TMO], 1u); break; } } } } while (0)
struct XcdBarrier { unsigned* bar; unsigned x; volatile LAS unsigned* st; };
__device__ __forceinline__ XcdBarrier xcd_barrier_post(unsigned* bar, volatile LAS unsigned* st) {
    XcdBarrier b; b.bar = bar; b.x = xb_xcc_id(); b.st = st;
    if (threadIdx.x == 0) (void)xb_add(&bar[XB_XCNT(b.x)], 1u);
    return b;
}
__device__ __forceinline__ void xcd_barrier_complete(unsigned* bar, unsigned x, unsigned& nloc, unsigned& nx) {
    const unsigned G = gridDim.x * gridDim.y * gridDim.z;
    unsigned sum, cnt, mine, sp = 0u;
    for (;;) {
        sum = 0u; cnt = 0u; mine = 0u;
#pragma unroll
        for (unsigned j = 0; j < 16; ++j) { const unsigned c = xb_ld(&bar[XB_XCNT(j)]); sum += c; cnt += (c > 0u) ? 1u : 0u; mine = (j == x) ? c : mine; }
        if (sum == G) break;
        __builtin_amdgcn_s_sleep(1);
        if ((++sp & 255u) == 0u) { if (xb_ld(&bar[XB_TMO])) break; if (sp > XB_SPIN_CAP) { atomicAdd(&bar[XB_TMO], 1u); break; } }
    }
    nloc = mine > 0u ? mine : 1u; nx = cnt > 0u ? cnt : 1u;
}
__device__ __forceinline__ void xcd_barrier(const XcdBarrier& b) {
    asm volatile("s_waitcnt vmcnt(0)" ::: "memory");
    __syncthreads();
    if (threadIdx.x == 0) {
        unsigned* bar = b.bar;
        __builtin_amdgcn_s_waitcnt(0);
        unsigned nloc = b.st[0], nx = b.st[1];
        if (nloc == 0u) { xcd_barrier_complete(bar, b.x, nloc, nx); b.st[0] = nloc; b.st[1] = nx; }
        const unsigned old = xb_add(&bar[XB_XSUB(b.x)], 1u);
        const unsigned gen = old / nloc;
        if (old + 1u == (gen + 1u) * nloc) {
            __builtin_amdgcn_fence(__ATOMIC_RELEASE, "agent");
            asm volatile("s_waitcnt vmcnt(0)" ::: "memory");
            const unsigned og = xb_add(&bar[XB_TOP], 1u);
            const unsigned tg = og / nx;
            if (og + 1u == (tg + 1u) * nx) xb_add(&bar[XB_TOPGEN], 1u);
            else XB_SPIN(xb_ld(&bar[XB_TOPGEN]) == tg, bar);
            __builtin_amdgcn_fence(__ATOMIC_ACQUIRE, "agent");
            xb_add(&bar[XB_XGEN(b.x)], 1u);
            asm volatile("s_waitcnt vmcnt(0)" ::: "memory");
        } else {
            XB_SPIN(xb_ld(&bar[XB_XGEN(b.x)]) == gen, bar);
            __builtin_amdgcn_fence(__ATOMIC_ACQUIRE, "agent");
            asm volatile("s_waitcnt vmcnt(0)" ::: "memory");
        }
    }
    __syncthreads();
}

struct Args { const float* in[24]; float* out; unsigned char* ws; int ph_lo, ph_hi; };
enum { IN_X = 0, IN_MEM, IN_NMIXG, IN_WIN, IN_GW2, IN_GB, IN_GNORM, IN_CONVW, IN_CONVB, IN_IGB, IN_FGB, IN_MNORM, IN_WOUT, IN_NCROSSG, IN_NMEMG,
       IN_WQ, IN_WK, IN_WV, IN_WO, IN_NFFNG, IN_WGATE, IN_WUP, IN_WDOWN, IN_NFING };

struct Frame {
    LAS unsigned char* lds;
    unsigned char* ws;
    int tid, lane, wave, vcu, G, bx;
};

struct CvtItem { const float* W; const float* g; bf16_t* Wt; int ldw, k0, sc0, K, dr0, nat; };
DI void cvt_load(const CvtItem& it, int lane, f32x4 (&v)[16], f32x4 (&gq)[4]) {
    const int kq = lane >> 4, nl = lane & 15;
    const float* src = it.W + (size_t)(it.k0 + 16 * kq) * it.ldw + it.sc0 + 4 * nl;
#pragma unroll
    for (int i = 0; i < 16; ++i) v[i] = __builtin_nontemporal_load((const f32x4*)(src + (size_t)i * it.ldw));
    if (it.g) { const f32x4* gp = (const f32x4*)(it.g + it.k0 + 16 * kq);
#pragma unroll
        for (int q = 0; q < 4; ++q) gq[q] = gp[q]; }
    else {
#pragma unroll
        for (int q = 0; q < 4; ++q) gq[q] = (f32x4){1.f, 1.f, 1.f, 1.f}; }
}
DI void cvt_pack(const f32x4 (&v)[16], const f32x4 (&gq)[4], u32x4 (&pk)[8]) {
#pragma unroll
    for (int e = 0; e < 4; ++e) {
        pk[2 * e].x = cvt_pk_bf16(v[0][e] * gq[0][0], v[1][e] * gq[0][1]); pk[2 * e].y = cvt_pk_bf16(v[2][e] * gq[0][2], v[3][e] * gq[0][3]);
        pk[2 * e].z = cvt_pk_bf16(v[4][e] * gq[1][0], v[5][e] * gq[1][1]); pk[2 * e].w = cvt_pk_bf16(v[6][e] * gq[1][2], v[7][e] * gq[1][3]);
        pk[2 * e + 1].x = cvt_pk_bf16(v[8][e] * gq[2][0], v[9][e] * gq[2][1]); pk[2 * e + 1].y = cvt_pk_bf16(v[10][e] * gq[2][2], v[11][e] * gq[2][3]);
        pk[2 * e + 1].z = cvt_pk_bf16(v[12][e] * gq[3][0], v[13][e] * gq[3][1]); pk[2 * e + 1].w = cvt_pk_bf16(v[14][e] * gq[3][2], v[15][e] * gq[3][3]);
    }
}
DI void cvt_store(const CvtItem& it, int lane, const u32x4 (&pk)[8]) {
    const int kq = lane >> 4, nl = lane & 15;
    if (it.nat) {
#pragma unroll
        for (int hf = 0; hf < 2; ++hf)
#pragma unroll
            for (int j = 0; j < 4; ++j) { const unsigned w0 = pk[0 + hf][j], w1 = pk[2 + hf][j], w2 = pk[4 + hf][j], w3 = pk[6 + hf][j];
                u32x2 r0, r1; r0.x = (w0 & 0xffffu) | (w1 << 16); r0.y = (w2 & 0xffffu) | (w3 << 16); r1.x = (w0 >> 16) | (w1 & 0xffff0000u); r1.y = (w2 >> 16) | (w3 & 0xffff0000u);
                bf16_t* dst = it.Wt + (size_t)(it.k0 + 16 * kq + 8 * hf + 2 * j) * it.K + it.dr0 + 4 * nl;
                *(u32x2*)dst = r0; *(u32x2*)(dst + it.K) = r1; }
        return; }
#pragma unroll
    for (int e = 0; e < 4; ++e) { bf16_t* dst = it.Wt + (size_t)(it.dr0 + 4 * nl + e) * it.K + it.k0 + 16 * kq; *(u32x4*)dst = pk[2 * e]; *(u32x4*)(dst + 8) = pk[2 * e + 1]; }
}
template <int MAT> constexpr int cvt_count() { return MAT == 0 ? 64 * 192 : MAT == 5 ? 64 * 344 : MAT == 6 ? 172 * 64 : 64 * 64; }
template <int MAT>
DI CvtItem cvt_item(const Args& a, unsigned char* ws, int r) {
    if constexpr (MAT == 0) { const int kb = r / 192, nb = r % 192, n0 = 64 * nb; return CvtItem{a.in[IN_WIN], a.in[IN_NMIXG], (bf16_t*)(ws + WS_WIN), INCOLS, 64 * kb, n0 < 6144 ? n0 : n0 + 16, D, n0, 0}; }
    else if constexpr (MAT == 1) return CvtItem{a.in[IN_WOUT], nullptr, (bf16_t*)(ws + WS_WOUT), D, 64 * (r / 64), 64 * (r % 64), D, 64 * (r % 64), 0};
    else if constexpr (MAT == 2) return CvtItem{a.in[IN_WK], nullptr, (bf16_t*)(ws + WS_WK), D, 64 * (r / 64), 64 * (r % 64), D, 64 * (r % 64), 0};
    else if constexpr (MAT == 3) return CvtItem{a.in[IN_WV], nullptr, (bf16_t*)(ws + WS_WV), D, 64 * (r / 64), 64 * (r % 64), D, 64 * (r % 64), 0};
    else if constexpr (MAT == 4) return CvtItem{a.in[IN_WO], nullptr, (bf16_t*)(ws + WS_WO), D, 64 * (r / 64), 64 * (r % 64), D, 64 * (r % 64), 0};
    else if constexpr (MAT == 5) { const int kb = r / 344, nb = r % 344, n0 = 64 * nb, pn = n0 >> 8, j0 = n0 & 255; const float* W = a.in[IN_WGATE]; const float* W2 = a.in[IN_WUP];
        return CvtItem{W + ((j0 < 128) ? 0 : (W2 - W)), a.in[IN_NFFNG], (bf16_t*)(ws + WS_WGU), FF, 64 * kb, 128 * pn + (j0 & 127), D, n0, 0}; }
    else if constexpr (MAT == 6) return CvtItem{a.in[IN_WDOWN], nullptr, (bf16_t*)(ws + WS_WDN), D, 64 * (r / 64), 64 * (r % 64), FF, 64 * (r % 64), 0};
    else return CvtItem{a.in[IN_WQ], a.in[IN_NCROSSG], (bf16_t*)(ws + WS_WQ), D, 64 * (r / 64), 64 * (r % 64), D, 64 * (r % 64), 1};
}
DI void cvt_pack_store(const CvtItem& it, int lane, const f32x4 (&v)[16], const f32x4 (&gq)[4]) {
    const int kq = lane >> 4, nl = lane & 15;
    if (it.nat) { u32x4 pk[8]; cvt_pack(v, gq, pk); cvt_store(it, lane, pk); return; }
#pragma unroll
    for (int e = 0; e < 4; ++e) { u32x4 lo, hi;
        lo.x = cvt_pk_bf16(v[0][e] * gq[0][0], v[1][e] * gq[0][1]); lo.y = cvt_pk_bf16(v[2][e] * gq[0][2], v[3][e] * gq[0][3]);
        lo.z = cvt_pk_bf16(v[4][e] * gq[1][0], v[5][e] * gq[1][1]); lo.w = cvt_pk_bf16(v[6][e] * gq[1][2], v[7][e] * gq[1][3]);
        hi.x = cvt_pk_bf16(v[8][e] * gq[2][0], v[9][e] * gq[2][1]); hi.y = cvt_pk_bf16(v[10][e] * gq[2][2], v[11][e] * gq[2][3]);
        hi.z = cvt_pk_bf16(v[12][e] * gq[3][0], v[13][e] * gq[3][1]); hi.w = cvt_pk_bf16(v[14][e] * gq[3][2], v[15][e] * gq[3][3]);
        bf16_t* dst = it.Wt + (size_t)(it.dr0 + 4 * nl + e) * it.K + it.k0 + 16 * kq; *(u32x4*)dst = lo; *(u32x4*)(dst + 8) = hi; }
}
template <int MAT>
DI void cvt_range(const Args& a, unsigned char* ws, int it0, int it1, int gw, int nw, int lane) {
    f32x4 v0[16], v1[16], g0[4], g1[4];
    int ia = it0 + gw, ib = ia + nw; const int st = 2 * nw;
    CvtItem ca = cvt_item<MAT>(a, ws, ia < it1 ? ia : it0), cb = cvt_item<MAT>(a, ws, ib < it1 ? ib : it0);
    if (ia < it1) cvt_load(ca, lane, v0, g0);
    if (ib < it1) cvt_load(cb, lane, v1, g1);
    while (ia < it1) {
        { cvt_pack_store(ca, lane, v0, g0); ia += st; if (ia < it1) { ca = cvt_item<MAT>(a, ws, ia); cvt_load(ca, lane, v0, g0); } }
        if (ib < it1) { cvt_pack_store(cb, lane, v1, g1); ib += st; if (ib < it1) { cb = cvt_item<MAT>(a, ws, ib); cvt_load(cb, lane, v1, g1); } }
    }
}
DI void p0a_weights(const Frame& F, const Args& a) {
    const int gw = F.vcu * NWAVES + F.wave, NGW = F.G * NWAVES, lane = F.lane;
    unsigned char* ws = F.ws;
    cvt_range<0>(a, ws, 0, cvt_count<0>(), gw, NGW, lane);
    { const float* win = a.in[IN_WIN]; const float* g = a.in[IN_NMIXG]; bf16_t* o = (bf16_t*)(ws + WS_WSMALL);
      for (int i = F.vcu * 512 + F.tid; i < 32 * D; i += F.G * 512) { const int c = i >> 12, k = i & (D - 1);
          float v = 0.f; if (c < 24) { const int col = c < 16 ? 6144 + c : 12304 + (c - 16); v = win[(size_t)k * INCOLS + col] * g[k]; }
          o[((((k >> 5) * 2 + (c >> 4)) * 64 + ((k >> 3) & 3) * 16 + (c & 15)) << 3) + (k & 7)] = (bf16_t)f2bf(v); } }
    { const float* mem = a.in[IN_MEM]; const float* g = a.in[IN_NMEMG]; bf16_t* o = (bf16_t*)(ws + WS_MEMN);
      for (int row = gw; row < 512; row += NGW) { const f32x4* xr = (const f32x4*)(mem + (size_t)row * D) + lane; f32x4 v[16]; float s = 0.f;
#pragma unroll
          for (int j = 0; j < 16; ++j) { v[j] = xr[64 * j]; s += (v[j][0] * v[j][0] + v[j][1] * v[j][1]) + (v[j][2] * v[j][2] + v[j][3] * v[j][3]); }
          const float rstd = __builtin_amdgcn_rsqf(wave_sum(s) * (1.f / D) + EPS);
#pragma unroll
          for (int j = 0; j < 16; ++j) { const f32x4 gv = *((const f32x4*)g + lane + 64 * j); const f32x4 y = v[j] * rstd * gv;
              u32x2 w; w.x = pk2(y[0], y[1]); w.y = pk2(y[2], y[3]); *((u32x2*)(o + (size_t)row * D) + lane + 64 * j) = w; } } }
}
constexpr int CW_Q = 8192;
template <int MAT>
DI void cvt_queue(const Frame& F, const Args& a) {
    unsigned char* ws = F.ws; unsigned* ctr = (unsigned*)(ws + WS_CTL) + CW_Q + 64 * MAT; const int lane = F.lane; constexpr int N = cvt_count<MAT>();
    for (;;) {
        unsigned g = 0; if (lane == 0) g = __hip_atomic_fetch_add(ctr, 1u, __ATOMIC_RELAXED, __HIP_MEMORY_SCOPE_AGENT);
        g = (unsigned)__builtin_amdgcn_readfirstlane((int)g);
        const int it0 = (int)g * 8; if (it0 >= N) break;
        cvt_range<MAT>(a, ws, it0, it0 + 8 < N ? it0 + 8 : N, 0, 1, lane);
    }
}
DI void p0a_rest(const Frame& F, const Args& a) {
    cvt_queue<2>(F, a); cvt_queue<3>(F, a); cvt_queue<1>(F, a); cvt_queue<7>(F, a); cvt_queue<4>(F, a); cvt_queue<5>(F, a); cvt_queue<6>(F, a);
}

DI void p0b_x(const Frame& F, const Args& a) {
    const int gw = F.vcu * NWAVES + F.wave, NGW = F.G * NWAVES, lane = F.lane, r = lane & 15, q4 = lane >> 4;
    const bool act = r < 8;
    const float* x = a.in[IN_X]; unsigned char* ws = F.ws;
    bf16_t* xb = (bf16_t*)a.out; const bf16_t* wsm = (const bf16_t*)(ws + WS_WSMALL); float* rstd0 = (float*)(ws + WS_RSTD0); float* smallp = (float*)(ws + WS_SMALLP);
    for (int task = gw; task < M / 8; task += NGW) {
        const int R0 = task * 8;
        const float* xr = x + (size_t)(R0 + (r & 7)) * D + 8 * q4; bf16_t* xo = xb + (size_t)(R0 + (r & 7)) * D + 8 * q4;
        const bf16_t* w0 = wsm + 8 * lane; const bf16_t* w1 = w0 + 512;
        f32x4 acc0 = {0.f, 0.f, 0.f, 0.f}, acc1 = {0.f, 0.f, 0.f, 0.f}; float ss = 0.f;
        for (int s0 = 0; s0 < 128; s0 += 8) {
            f32x4 xa[8], xc[8]; bf16x8 b0[8], b1[8];
#pragma unroll
            for (int u = 0; u < 8; ++u) { xa[u] = (f32x4){0.f, 0.f, 0.f, 0.f}; xc[u] = xa[u]; if (act) { xa[u] = __builtin_nontemporal_load((const f32x4*)(xr + 32 * (s0 + u))); xc[u] = __builtin_nontemporal_load((const f32x4*)(xr + 32 * (s0 + u) + 4)); } }
#pragma unroll
            for (int u = 0; u < 8; ++u) { b0[u] = *(const bf16x8*)(w0 + 1024 * (s0 + u)); b1[u] = *(const bf16x8*)(w1 + 1024 * (s0 + u)); }
#pragma unroll
            for (int u = 0; u < 8; ++u) { const f32x4 p = xa[u], q = xc[u];
                ss += (p[0] * p[0] + p[1] * p[1]) + (p[2] * p[2] + p[3] * p[3]) + (q[0] * q[0] + q[1] * q[1]) + (q[2] * q[2] + q[3] * q[3]);
                u32x4 w; w.x = cvt_pk_bf16(p[0], p[1]); w.y = cvt_pk_bf16(p[2], p[3]); w.z = cvt_pk_bf16(q[0], q[1]); w.w = cvt_pk_bf16(q[2], q[3]);
                if (act) *(u32x4*)(xo + 32 * (s0 + u)) = w; const bf16x8 af = __builtin_bit_cast(bf16x8, w);
                acc0 = __builtin_amdgcn_mfma_f32_16x16x32_bf16(af, b0[u], acc0, 0, 0, 0); acc1 = __builtin_amdgcn_mfma_f32_16x16x32_bf16(af, b1[u], acc1, 0, 0, 0); }
        }
        ss += __shfl_xor(ss, 16); ss += __shfl_xor(ss, 32);
        const float rstd = __builtin_amdgcn_rsqf(ss * (1.f / D) + EPS);
        if (q4 == 0 && act) rstd0[R0 + r] = rstd;
#pragma unroll
        for (int reg = 0; reg < 4; ++reg) { const int row = 4 * q4 + reg; const float rsr = __shfl(rstd, row & 7);
            if (q4 < 2) { smallp[(size_t)(R0 + row) * 32 + r] = acc0[reg] * rsr; smallp[(size_t)(R0 + row) * 32 + 16 + r] = acc1[reg] * rsr; } }
    }
}

constexpr int QT_STRIDE = 528;
constexpr int PRE_QT = 0, PRE_KT = 64 * QT_STRIDE, PRE_PT = 2 * 64 * QT_STRIDE, PT_STRIDE = 272;
constexpr int PRE_MISC = PRE_PT + 64 * PT_STRIDE;
DI void pre_fetch(const Frame& F, int it, u32x4 (&qv4)[4], u32x4 (&kv4)[4]) {
    const int s = it >> 7, n = it & 127, b = (s >> 2) & 1, h = s & 3, tid = F.tid; const bool ml = s >= 8;
    const bf16_t* proj = (const bf16_t*)(F.ws + WS_PROJ) + (size_t)(b * SEQ + n * 64) * NPROJ + h * 256;
    const bf16_t* qsrc = proj + (ml ? C_QM : C_QG); const bf16_t* ksrc = proj + (ml ? C_KM : C_KG);
#pragma unroll
    for (int i = 0; i < 4; ++i) { const int p = tid + 512 * i, t = p >> 5, c8 = p & 31; qv4[i] = __builtin_nontemporal_load((const u32x4*)(qsrc + (size_t)t * NPROJ + 8 * c8)); kv4[i] = __builtin_nontemporal_load((const u32x4*)(ksrc + (size_t)t * NPROJ + 8 * c8)); }
}
template <bool ML>
DI void pre_item(const Frame& F, const Args& a, int s, int n, u32x4 (&qv4)[4], u32x4 (&kv4)[4], int nxt) {
    LAS unsigned char* lds = F.lds; unsigned char* ws = F.ws;
    const int tid = F.tid, lane = F.lane, wave = F.wave;
    const int b = (s >> 2) & 1, h = s & 3, sl = s & 7;
    const int T0 = b * SEQ + n * 64;
    const bf16_t* proj = (const bf16_t*)(ws + WS_PROJ); const float* smallp = (const float*)(ws + WS_SMALLP);
    LAS float* AG = (LAS float*)(lds + PRE_MISC); LAS float* HT = AG + 1024; LAS float* BB = HT + 256; LAS float* UU = BB + 64; LAS float* MLc = UU + 64; LAS float* WL = MLc + 64; LAS float* EE = WL + 64; LAS float* GG = EE + 64;
    const int d = tid & 255, th = tid >> 8;
    {
#pragma unroll
      for (int i = 0; i < 4; ++i) { const int p = tid + 512 * i, t = p >> 5, c8 = p & 31; *(LAS u32x4*)(lds + PRE_QT + t * QT_STRIDE + 16 * c8) = qv4[i]; *(LAS u32x4*)(lds + PRE_KT + t * QT_STRIDE + 16 * c8) = kv4[i]; } }
    if (!ML) {
        if (tid < 256) { const int t = tid >> 2, r4 = tid & 3; *(LAS f32x4*)(AG + t * 16 + 4 * r4) = *(const f32x4*)(smallp + (size_t)(T0 + t) * 32 + 4 * r4); }
        __syncthreads();
        float w2c[16]; const float* w2 = a.in[IN_GW2];
#pragma unroll
        for (int r = 0; r < 16; ++r) w2c[r] = w2[r * 1024 + h * 256 + d];
        const float gb = a.in[IN_GB][h * 256 + d];
        pre_fetch(F, nxt, qv4, kv4);
        float la[32]; float run = 0.f;
#pragma unroll
        for (int i = 0; i < 32; ++i) { const int t = 32 * th + i; float xg = gb;
#pragma unroll
            for (int q = 0; q < 4; ++q) { const f32x4 av = *(const LAS f32x4*)(AG + t * 16 + 4 * q); xg += av[0] * w2c[4 * q] + av[1] * w2c[4 * q + 1] + av[2] * w2c[4 * q + 2] + av[3] * w2c[4 * q + 3]; }
            la[i] = logsigmoidf(xg) * 0.0625f; run += la[i]; }
        if (th == 0) HT[d] = run;
        __syncthreads();
        float bc = th ? HT[d] : 0.f;
#pragma unroll
        for (int i = 0; i < 32; ++i) { const int t = 32 * th + i; bc += la[i];
            const float qv = bf2f(*(const LAS bf16_t*)(lds + PRE_QT + t * QT_STRIDE + 2 * d)), kv = bf2f(*(const LAS bf16_t*)(lds + PRE_KT + t * QT_STRIDE + 2 * d));
            const unsigned qk2 = cvt_pk_bf16(qv * 0.0625f * __expf(bc), kv * __expf(-bc));
            *(LAS bf16_t*)(lds + PRE_QT + t * QT_STRIDE + 2 * d) = (bf16_t)(qk2 & 0xffffu);
            *(LAS bf16_t*)(lds + PRE_KT + t * QT_STRIDE + 2 * d) = (bf16_t)(qk2 >> 16); }
        if (th == 1) ((float*)(ws + WS_DEC))[((size_t)sl * NCH + n) * 256 + d] = __expf(bc);
    } else {
        if (wave == 0) { const int t = lane;
            const float im = smallp[(size_t)(T0 + t) * 32 + 16 + h], fm = smallp[(size_t)(T0 + t) * 32 + 20 + h];
            const float ib = im + a.in[IN_IGB][h], lf = logsigmoidf(fm + a.in[IN_FGB][h]);
            float bb = lf;
#pragma unroll
            for (int o = 1; o < 64; o <<= 1) { const float y = __shfl_up(bb, o); if (lane >= o) bb += y; }
            const float u = ib - bb; float cm = u;
#pragma unroll
            for (int o = 1; o < 64; o <<= 1) { const float y = __shfl_up(cm, o); if (lane >= o) cm = fmaxf(cm, y); }
            const float blast = __shfl(bb, 63), cmax = __shfl(cm, 63);
            BB[t] = bb; UU[t] = u; MLc[t] = bb + cm; WL[t] = __expf(u - cmax); (void)blast;
            const float* egx = (const float*)(ws + WS_EGX) + (size_t)sl * 3 * SEQ + n * 64 + t;
            EE[t] = egx[0]; GG[t] = egx[SEQ];
        }
        __syncthreads();
        const float* cw = a.in[IN_CONVW]; const float* cb = a.in[IN_CONVB];
        const int chq = h * 256 + d, chk = 1024 + h * 256 + d;
        float wq[4], wk[4];
#pragma unroll
        for (int j = 0; j < 4; ++j) { wq[j] = cw[j * 2048 + chq]; wk[j] = cw[j * 2048 + chk]; }
        const float bq = cb[chq], bk = cb[chk];
        const int tfirst = 32 * th;
        float xq[3], xk[3];
        if (th) {
#pragma unroll
            for (int j = 0; j < 3; ++j) { xq[j] = bf2f(*(const LAS bf16_t*)(lds + PRE_QT + (29 + j) * QT_STRIDE + 2 * d)); xk[j] = bf2f(*(const LAS bf16_t*)(lds + PRE_KT + (29 + j) * QT_STRIDE + 2 * d)); }
        } else { const bf16_t* qp = proj + (size_t)T0 * NPROJ + C_QM + h * 256 + d; const bf16_t* kp = proj + (size_t)T0 * NPROJ + C_KM + h * 256 + d;
#pragma unroll
            for (int j = 0; j < 3; ++j) { const size_t back = (n > 0) ? (size_t)(3 - j) * NPROJ : 0; const float vq = bf2f(*(qp - back)), vk = bf2f(*(kp - back)); xq[j] = (n > 0) ? vq : 0.f; xk[j] = (n > 0) ? vk : 0.f; } }
        __syncthreads();
        pre_fetch(F, nxt, qv4, kv4);
        float ks = 0.f;
#pragma unroll
        for (int i = 0; i < 32; ++i) { const int t = tfirst + i;
            const float cq = bf2f(*(const LAS bf16_t*)(lds + PRE_QT + t * QT_STRIDE + 2 * d)), ck = bf2f(*(const LAS bf16_t*)(lds + PRE_KT + t * QT_STRIDE + 2 * d));
            const float yq = bq + wq[0] * xq[0] + wq[1] * xq[1] + wq[2] * xq[2] + wq[3] * cq;
            const float yk = bk + wk[0] * xk[0] + wk[1] * xk[1] + wk[2] * xk[2] + wk[3] * ck;
            xq[0] = xq[1]; xq[1] = xq[2]; xq[2] = cq; xk[0] = xk[1]; xk[1] = xk[2]; xk[2] = ck;
            const float qv = siluf_(yq), kv = siluf_(yk) * 0.0625f;
            const unsigned qk2 = cvt_pk_bf16(qv, kv);
            *(LAS bf16_t*)(lds + PRE_QT + t * QT_STRIDE + 2 * d) = (bf16_t)(qk2 & 0xffffu);
            *(LAS bf16_t*)(lds + PRE_KT + t * QT_STRIDE + 2 * d) = (bf16_t)(qk2 >> 16);
            ks += bfhi(qk2) * WL[t]; }
        if (th == 0) HT[d] = ks;
        __syncthreads();
        if (th == 1) ((float*)(ws + WS_KSUM))[((size_t)sl * NCH + n) * 256 + d] = ks + HT[d];
    }
    __syncthreads();
    bf16_t* Aq = (bf16_t*)(ws + (ML ? WS_AQM : WS_AQG)) + ((size_t)sl * NCH + n) * 16384;
    bf16_t* Ak = (bf16_t*)(ws + (ML ? WS_AKM : WS_AKG)) + ((size_t)sl * NCH + n) * 16384;
    bf16_t* Pm = (bf16_t*)(ws + (ML ? WS_PMM : WS_PMG)) + ((size_t)sl * NCH + n) * 4096;
#pragma unroll
    for (int i = 0; i < 4; ++i) { const int p = tid + 512 * i, w = p >> 8, tb = (p >> 7) & 1, ks = (p >> 6) & 1, l = p & 63, r = l & 31, hh = l >> 5;
        const int t = 32 * tb + r, d0 = 32 * w + 16 * ks + 4 * hh;
        const u32x2 lo = *(const LAS u32x2*)(lds + PRE_QT + t * QT_STRIDE + 2 * d0), hi = *(const LAS u32x2*)(lds + PRE_QT + t * QT_STRIDE + 2 * (d0 + 8));
        u32x4 o4 = (u32x4){lo.x, lo.y, hi.x, hi.y};
        if (ML) { const float gs = GG[t]; o4.x = cvt_pk_bf16(bflo(lo.x) * gs, bfhi(lo.x) * gs); o4.y = cvt_pk_bf16(bflo(lo.y) * gs, bfhi(lo.y) * gs); o4.z = cvt_pk_bf16(bflo(hi.x) * gs, bfhi(hi.x) * gs); o4.w = cvt_pk_bf16(bflo(hi.y) * gs, bfhi(hi.y) * gs); }
        *(u32x4*)(Aq + (size_t)p * 8) = o4; }
#pragma unroll
    for (int i = 0; i < 4; ++i) { const int p = tid + 512 * i, w = p >> 8, ks4 = (p >> 6) & 3, l = p & 63, r = l & 31, hh = l >> 5;
        const int dd = 32 * w + r, t0 = 16 * ks4 + 8 * hh; float kv[8];
#pragma unroll
        for (int j = 0; j < 8; ++j) { kv[j] = bf2f(*(const LAS bf16_t*)(lds + PRE_KT + (t0 + j) * QT_STRIDE + 2 * dd)); if (ML) kv[j] *= WL[t0 + j]; }
        u32x4 o; o.x = cvt_pk_bf16(kv[0], kv[1]); o.y = cvt_pk_bf16(kv[2], kv[3]); o.z = cvt_pk_bf16(kv[4], kv[5]); o.w = cvt_pk_bf16(kv[6], kv[7]);
        *(u32x4*)(Ak + (size_t)p * 8) = o; }
    { const int r16 = lane & 15, q4 = lane >> 4, tt = wave >> 1;
#pragma unroll
      for (int e2 = 0; e2 < 2; ++e2) { const int st = 2 * (wave & 1) + e2; f32x4 c = {0.f, 0.f, 0.f, 0.f};
          if (st <= tt) {
#pragma unroll
              for (int k = 0; k < 8; ++k) { const bf16x8 af = *(const LAS bf16x8*)(lds + PRE_QT + (16 * tt + r16) * QT_STRIDE + 2 * (32 * k + 8 * q4));
                  const bf16x8 bfr = *(const LAS bf16x8*)(lds + PRE_KT + (16 * st + r16) * QT_STRIDE + 2 * (32 * k + 8 * q4));
                  c = __builtin_amdgcn_mfma_f32_16x16x32_bf16(af, bfr, c, 0, 0, 0); } }
          const int scol = 16 * st + r16;
#pragma unroll
          for (int reg = 0; reg < 4; ++reg) { const int t = 16 * tt + 4 * q4 + reg; float v = (scol <= t) ? c[reg] : 0.f;
              if (ML) v = (scol <= t) ? v * (EE[t] * __expf(BB[t] - MLc[t] + UU[scol])) : 0.f;
              *(LAS float*)(lds + PRE_PT + t * PT_STRIDE + 4 * scol) = v; } } }
    __syncthreads();
    if (ML && tid < 64) { float rsum = 0.f;
#pragma unroll 8
        for (int j = 0; j < 64; ++j) rsum += *(const LAS float*)(lds + PRE_PT + tid * PT_STRIDE + 4 * j);
        ((float*)(ws + WS_RP))[(size_t)sl * SEQ + n * 64 + tid] = rsum; }
    { const int p = tid, tb = p >> 8, ks4 = (p >> 6) & 3, l = p & 63, r = l & 31, hh = l >> 5; const int t = 32 * tb + r, s0 = 16 * ks4 + 8 * hh;
      const f32x4 x0 = *(const LAS f32x4*)(lds + PRE_PT + t * PT_STRIDE + 4 * s0), x1 = *(const LAS f32x4*)(lds + PRE_PT + t * PT_STRIDE + 4 * (s0 + 4));
      u32x4 o; o.x = cvt_pk_bf16(x0[0], x0[1]); o.y = cvt_pk_bf16(x0[2], x0[3]); o.z = cvt_pk_bf16(x1[0], x1[1]); o.w = cvt_pk_bf16(x1[2], x1[3]);
      *(u32x4*)(Pm + (size_t)p * 8) = o; }
    __syncthreads();
}

DI void gate_scan(const Frame& F, const Args& a, int sl) {
    LAS float* sc = (LAS float*)F.lds;
    const int b = sl >> 2, h = sl & 3, lane = F.lane, w = F.wave;
    const float* smallp = (const float*)(F.ws + WS_SMALLP);
    const float bi = a.in[IN_IGB][h], bfg = a.in[IN_FGB][h];
    float bbv[16], mlv[16];
#pragma unroll
    for (int i = 0; i < 16; ++i) { const int n = w + 8 * i; const size_t row = (size_t)b * SEQ + n * 64 + lane;
        const float ib = smallp[row * 32 + 16 + h] + bi, lf = logsigmoidf(smallp[row * 32 + 20 + h] + bfg);
        float bb = lf;
#pragma unroll
        for (int o = 1; o < 64; o <<= 1) { const float y = __shfl_up(bb, o); if (lane >= o) bb += y; }
        const float u = ib - bb; float cm = u;
#pragma unroll
        for (int o = 1; o < 64; o <<= 1) { const float y = __shfl_up(cm, o); if (lane >= o) cm = fmaxf(cm, y); }
        const float blast = __shfl(bb, 63), cmax = __shfl(cm, 63);
        bbv[i] = bb; mlv[i] = bb + cm; if (lane == 0) { sc[2 * n] = blast; sc[2 * n + 1] = blast + cmax; } }
    __syncthreads();
    if (F.tid == 0) { float m = 0.f; float* db = (float*)(F.ws + WS_DB) + (size_t)sl * NCH * 2;
        for (int n = 0; n < NCH; ++n) { sc[256 + n] = m; const float bl = sc[2 * n], cn = sc[2 * n + 1], mn = fmaxf(bl + m, cn);
            db[2 * n] = __expf(bl + m - mn); db[2 * n + 1] = __expf(cn - mn); m = mn; } }
    __syncthreads();
    float* egx = (float*)(F.ws + WS_EGX) + (size_t)sl * 3 * SEQ;
#pragma unroll
    for (int i = 0; i < 16; ++i) { const int n = w + 8 * i; const float mp = sc[256 + n], il = bbv[i] + mp, mt = fmaxf(il, mlv[i]);
        egx[n * 64 + lane] = __expf(mlv[i] - mt); egx[SEQ + n * 64 + lane] = __expf(il - mt); egx[2 * SEQ + n * 64 + lane] = __expf(-mt); }
    __syncthreads();
}

DI bf16x8 pack8(float a0, float a1, float a2, float a3, float a4, float a5, float a6, float a7) {
    u32x4 p; p.x = cvt_pk_bf16(a0, a1); p.y = cvt_pk_bf16(a2, a3); p.z = cvt_pk_bf16(a4, a5); p.w = cvt_pk_bf16(a6, a7);
    return __builtin_bit_cast(bf16x8, p);
}
#define MFMA32(a, b, c) __builtin_amdgcn_mfma_f32_32x32x16_bf16((a), (b), (c), 0, 0, 0)
struct ScanOps { u32x4 aq[4], ak[4], pm; f32x4 dec[4]; float sc, ks; };
struct ScanCtx {
    LAS unsigned char* lds; const unsigned char *aqB, *akB, *pmB, *decB, *vB, *pfA, *pfV; const float *dbB, *ksB; float* npB; bf16_t* outp;
    size_t pfAstep; unsigned lo16, vaddr; int tid, lane, w, c, hh, slice;
};
template <bool ML>
DI void scan_load(const ScanCtx& X, ScanOps& o, int n) {
#pragma unroll
    for (int f = 0; f < 4; ++f) { o.aq[f] = *(const u32x4*)(X.aqB + (size_t)n * 32768 + f * 1024 + X.lo16); o.ak[f] = *(const u32x4*)(X.akB + (size_t)n * 32768 + f * 1024 + X.lo16); }
    o.pm = *(const u32x4*)(X.pmB + (size_t)n * 8192 + X.lo16);
    if (!ML) {
#pragma unroll
        for (int g = 0; g < 4; ++g) o.dec[g] = *(const f32x4*)(X.decB + (size_t)n * 1024 + 32 * g + 16 * X.hh);
    } else { o.sc = X.dbB[n * 2 + (X.lane & 1)]; if (X.slice == 0) o.ks = X.ksB[(size_t)n * 256]; }
}
template <bool ML, int PAR>
DI void scan_step(const ScanCtx& X, const ScanOps& cur, ScanOps& nxt, f32x16& S, float& nreg, int n, u32x4& vnew, const u32x4& vold) {
    LAS unsigned char* lds = X.lds; const int w = X.w, c = X.c, hh = X.hh;
    constexpr int PF = 4;
    u32x4 pf0 = {0u, 0u, 0u, 0u}, pf1 = {0u, 0u, 0u, 0u};
    if (n + PF < NCH) { if (X.tid < 288) pf0 = *(const u32x4*)(X.pfA + (size_t)(n + PF) * X.pfAstep); if (X.tid < 256) pf1 = *(const u32x4*)(X.pfV + (size_t)(n + PF) * (64 * NPROJ * 2)); }
    const bool more = (n + 1 < NCH);
    if (n + 2 < NCH && X.tid < 256) vnew = *(const u32x4*)(X.vB + (size_t)(n + 2) * (64 * NPROJ * 2));
    scan_load<ML>(X, nxt, more ? n + 1 : n);
    u32x2 tv[8];
    { const unsigned va = X.vaddr + (unsigned)(n & 3) * 4096u;
      asm volatile("ds_read_b64_tr_b16 %0, %8\n\tds_read_b64_tr_b16 %1, %8 offset:256\n\tds_read_b64_tr_b16 %2, %8 offset:1024\n\tds_read_b64_tr_b16 %3, %8 offset:1280\n\t"
                   "ds_read_b64_tr_b16 %4, %8 offset:2048\n\tds_read_b64_tr_b16 %5, %8 offset:2304\n\tds_read_b64_tr_b16 %6, %8 offset:3072\n\tds_read_b64_tr_b16 %7, %8 offset:3328\n\t"
                   "s_waitcnt lgkmcnt(0)"
                   : "=&v"(tv[0]), "=&v"(tv[1]), "=&v"(tv[2]), "=&v"(tv[3]), "=&v"(tv[4]), "=&v"(tv[5]), "=&v"(tv[6]), "=&v"(tv[7]) : "v"(va) : "memory"); }
    bf16x8 Bv[4];
#pragma unroll
    for (int k = 0; k < 4; ++k) Bv[k] = __builtin_bit_cast(bf16x8, (u32x4){tv[2 * k].x, tv[2 * k].y, tv[2 * k + 1].x, tv[2 * k + 1].y});
    const bf16x8 Bs0 = pack8(S[0], S[1], S[2], S[3], S[4], S[5], S[6], S[7]);
    const bf16x8 Bs1 = pack8(S[8], S[9], S[10], S[11], S[12], S[13], S[14], S[15]);
    f32x16 zero;
#pragma unroll
    for (int i = 0; i < 16; ++i) zero[i] = 0.f;
    f32x16 o0 = MFMA32(__builtin_bit_cast(bf16x8, cur.aq[0]), Bs0, zero); o0 = MFMA32(__builtin_bit_cast(bf16x8, cur.aq[1]), Bs1, o0);
    f32x16 o1 = MFMA32(__builtin_bit_cast(bf16x8, cur.aq[2]), Bs0, zero); o1 = MFMA32(__builtin_bit_cast(bf16x8, cur.aq[3]), Bs1, o1);
    { const bf16x8 pa = __builtin_bit_cast(bf16x8, cur.pm); bf16x8 bsel;
      if ((w >> 1) == 0) bsel = Bv[0]; else if ((w >> 1) == 1) bsel = Bv[1]; else if ((w >> 1) == 2) bsel = Bv[2]; else bsel = Bv[3];
      if ((w & 1) == 0) o0 = MFMA32(pa, bsel, o0); else o1 = MFMA32(pa, bsel, o1); }
    f32x16 U = MFMA32(__builtin_bit_cast(bf16x8, cur.ak[0]), Bv[0], zero);
    U = MFMA32(__builtin_bit_cast(bf16x8, cur.ak[1]), Bv[1], U); U = MFMA32(__builtin_bit_cast(bf16x8, cur.ak[2]), Bv[2], U); U = MFMA32(__builtin_bit_cast(bf16x8, cur.ak[3]), Bv[3], U);
    { LAS unsigned char* img = lds + PAR * 65536 + w * 8192 + c * 256;
#pragma unroll
      for (int g = 0; g < 4; ++g) { const int tq0 = 2 * g + hh, tq1 = 8 + 2 * g + hh;
          *(LAS f32x4*)(img + ((tq0 + c) & 15) * 16) = (f32x4){o0[4 * g], o0[4 * g + 1], o0[4 * g + 2], o0[4 * g + 3]};
          *(LAS f32x4*)(img + ((tq1 + c) & 15) * 16) = (f32x4){o1[4 * g], o1[4 * g + 1], o1[4 * g + 2], o1[4 * g + 3]}; } }
    if (!ML) {
#pragma unroll
        for (int i = 0; i < 16; ++i) S[i] = cur.dec[i >> 2][i & 3] * (S[i] + U[i]);
    } else {
        const float decay = __builtin_bit_cast(float, __builtin_amdgcn_readlane(__builtin_bit_cast(int, cur.sc), 0)), beta = __builtin_bit_cast(float, __builtin_amdgcn_readlane(__builtin_bit_cast(int, cur.sc), 1));
#pragma unroll
        for (int i = 0; i < 16; ++i) S[i] = decay * S[i] + beta * U[i];
        if (X.slice == 0 && hh == 0) { X.npB[(size_t)n * 256] = nreg; nreg = decay * nreg + beta * cur.ks; }
    }
    if (more && X.tid < 256) *(LAS u32x4*)(lds + LDS_X0 + ((n + 1) & 3) * 4096 + X.tid * 16) = vold;
    asm volatile("s_waitcnt lgkmcnt(0)" ::: "memory"); __builtin_amdgcn_s_barrier(); asm volatile("" ::: "memory");
    { const int tq = 2 * w + hh; f32x4 acc = {0.f, 0.f, 0.f, 0.f};
      const LAS unsigned char* img = lds + PAR * 65536 + c * 256 + ((tq + c) & 15) * 16;
#pragma unroll
      for (int w2 = 0; w2 < 8; ++w2) acc = acc + *(const LAS f32x4*)(img + w2 * 8192);
      bf16_t* op = X.outp + ((size_t)n * 64 + 4 * tq) * 2048;
      const unsigned p01 = cvt_pk_bf16(acc[0], acc[1]), p23 = cvt_pk_bf16(acc[2], acc[3]);
      op[0] = (bf16_t)(p01 & 0xffffu); op[2048] = (bf16_t)(p01 >> 16); op[2 * 2048] = (bf16_t)(p23 & 0xffffu); op[3 * 2048] = (bf16_t)(p23 >> 16); }
    asm volatile("" :: "v"(pf0.x), "v"(pf1.x));
}
template <bool ML>
DI void scan_stream(const Frame& F, const Args& a, int s, int slice) {
    unsigned char* ws = F.ws;
    const int b = (s >> 2) & 1, h = s & 3, sl = s & 7;
    const size_t T0 = (size_t)b * SEQ;
    ScanCtx X;
    X.lds = F.lds; X.tid = F.tid; X.lane = F.lane; X.w = F.wave; X.c = F.lane & 31; X.hh = F.lane >> 5; X.slice = slice; X.lo16 = (unsigned)F.lane * 16u;
    const unsigned char* proj = ws + WS_PROJ;
    const int vcol = (ML ? C_VM : C_VG) + h * 512 + 32 * slice;
    X.outp = (bf16_t*)(ws + (ML ? WS_OUTM : WS_OUTG)) + T0 * 2048 + h * 512 + 32 * slice + X.c;
    X.aqB = ws + (ML ? WS_AQM : WS_AQG) + (size_t)sl * NCH * 32768 + X.w * 4096;
    X.akB = ws + (ML ? WS_AKM : WS_AKG) + (size_t)sl * NCH * 32768 + X.w * 4096;
    X.pmB = ws + (ML ? WS_PMM : WS_PMG) + (size_t)sl * NCH * 8192 + ((X.w & 1) * 4 + (X.w >> 1)) * 1024;
    X.decB = ws + WS_DEC + ((size_t)sl * NCH * 256 + 32 * X.w) * 4;
    X.dbB = (const float*)(ws + WS_DB) + (size_t)sl * NCH * 2;
    X.ksB = (const float*)(ws + WS_KSUM) + (size_t)sl * NCH * 256 + 32 * X.w + X.c;
    X.npB = (float*)(ws + WS_NPREV) + (size_t)sl * NCH * 256 + 32 * X.w + X.c;
    X.vB = proj + ((T0 + (F.tid >> 2)) * NPROJ + vcol + 8 * (F.tid & 3)) * 2;
    X.vaddr = (unsigned)(size_t)(F.lds + LDS_X0) + (8 * X.hh + ((F.lane & 15) >> 2)) * 64 + 32 * ((F.lane >> 4) & 1) + 8 * (F.lane & 3);
    { const int pq = slice * 288 + F.tid;
      X.pfA = (pq < 2048) ? ws + (ML ? WS_AQM : WS_AQG) + ((size_t)sl * NCH * 2048 + pq) * 16
            : (pq < 4096) ? ws + (ML ? WS_AKM : WS_AKG) + ((size_t)sl * NCH * 2048 + (pq - 2048)) * 16
                          : ws + (ML ? WS_PMM : WS_PMG) + ((size_t)sl * NCH * 512 + (pq - 4096)) * 16;
      X.pfAstep = (pq < 4096) ? 32768 : 8192;
      X.pfV = proj + ((T0 + 4 * slice + (F.tid >> 6)) * NPROJ + (ML ? C_VM : C_VG) + h * 512 + 8 * (F.tid & 63)) * 2; }
    f32x16 S;
#pragma unroll
    for (int i = 0; i < 16; ++i) S[i] = 0.f;
    float nreg = 0.f;
    ScanOps A, B;
    A.sc = 0.f; A.ks = 0.f; B.sc = 0.f; B.ks = 0.f;
    scan_load<ML>(X, A, 0);
    u32x4 vA = {0u, 0u, 0u, 0u}, vB = {0u, 0u, 0u, 0u};
    if (F.tid < 256) { const u32x4 v0 = *(const u32x4*)X.vB; vB = *(const u32x4*)(X.vB + (size_t)(64 * NPROJ * 2)); *(LAS u32x4*)(F.lds + LDS_X0 + F.tid * 16) = v0; }
    __syncthreads();
    for (int n = 0; n < NCH; n += 2) {
        scan_step<ML, 0>(X, A, B, S, nreg, n, vA, vB);
        scan_step<ML, 1>(X, B, A, S, nreg, n + 1, vB, vA);
    }
    __syncthreads();
}

struct Scan2Ops { u32x4 aq[4], ak[4]; };
template <bool ML>
DI void scan2_load(const ScanCtx& X, Scan2Ops& o, int n) {
#pragma unroll
    for (int f = 0; f < 4; ++f) { o.aq[f] = *(const u32x4*)(X.aqB + (size_t)n * 32768 + f * 1024 + X.lo16); o.ak[f] = *(const u32x4*)(X.akB + (size_t)n * 32768 + f * 1024 + X.lo16); }
}
template <bool ML, int PAR>
DI void scan2_step(const ScanCtx& X, const Scan2Ops& cur, Scan2Ops& nxt, f32x16& S0, f32x16& S1, float& nreg, int n) {
    LAS unsigned char* lds = X.lds; const int w = X.w, c = X.c, hh = X.hh;
    const bool more = (n + 1 < NCH);
    u32x4 vnext = {0u, 0u, 0u, 0u};
    const u32x4 cpm = *(const u32x4*)(X.pmB + (size_t)n * 8192 + X.lo16);
    scan2_load<ML>(X, nxt, more ? n + 1 : n);
    f32x4 dec[4]; float csc = 0.f, cks = 0.f;
    if (!ML) {
#pragma unroll
        for (int g = 0; g < 4; ++g) dec[g] = *(const f32x4*)(X.decB + (size_t)n * 1024 + 32 * g + 16 * X.hh);
    } else { csc = X.dbB[n * 2 + (X.lane & 1)]; if (X.slice == 0) cks = X.ksB[(size_t)n * 256]; }
    f32x16 zero;
#pragma unroll
    for (int i = 0; i < 16; ++i) zero[i] = 0.f;
    float decay = 1.f, beta = 1.f;
    if (ML) { decay = __builtin_bit_cast(float, __builtin_amdgcn_readlane(__builtin_bit_cast(int, csc), 0)); beta = __builtin_bit_cast(float, __builtin_amdgcn_readlane(__builtin_bit_cast(int, csc), 1)); }
    LAS unsigned char* img = lds + PAR * 65536 + w * 8192;
#pragma unroll
    for (int ct = 0; ct < 2; ++ct) {
        u32x2 tv[8];
        { const unsigned va = X.vaddr + (unsigned)(n & 1) * 8192u + (unsigned)ct * 64u;
          asm volatile("ds_read_b64_tr_b16 %0, %8\n\tds_read_b64_tr_b16 %1, %8 offset:512\n\tds_read_b64_tr_b16 %2, %8 offset:2048\n\tds_read_b64_tr_b16 %3, %8 offset:2560\n\t"
                       "ds_read_b64_tr_b16 %4, %8 offset:4096\n\tds_read_b64_tr_b16 %5, %8 offset:4608\n\tds_read_b64_tr_b16 %6, %8 offset:6144\n\tds_read_b64_tr_b16 %7, %8 offset:6656\n\t"
                       "s_waitcnt lgkmcnt(0)"
                       : "=&v"(tv[0]), "=&v"(tv[1]), "=&v"(tv[2]), "=&v"(tv[3]), "=&v"(tv[4]), "=&v"(tv[5]), "=&v"(tv[6]), "=&v"(tv[7]) : "v"(va) : "memory"); }
        bf16x8 Bv[4];
#pragma unroll
        for (int k = 0; k < 4; ++k) Bv[k] = __builtin_bit_cast(bf16x8, (u32x4){tv[2 * k].x, tv[2 * k].y, tv[2 * k + 1].x, tv[2 * k + 1].y});
        const bf16x8 Ba = ct ? pack8(S1[0], S1[1], S1[2], S1[3], S1[4], S1[5], S1[6], S1[7]) : pack8(S0[0], S0[1], S0[2], S0[3], S0[4], S0[5], S0[6], S0[7]);
        const bf16x8 Bb = ct ? pack8(S1[8], S1[9], S1[10], S1[11], S1[12], S1[13], S1[14], S1[15]) : pack8(S0[8], S0[9], S0[10], S0[11], S0[12], S0[13], S0[14], S0[15]);
        { const bf16x8 pa = __builtin_bit_cast(bf16x8, cpm); bf16x8 bsel;
          if ((w >> 1) == 0) bsel = Bv[0]; else if ((w >> 1) == 1) bsel = Bv[1]; else if ((w >> 1) == 2) bsel = Bv[2]; else bsel = Bv[3];
          LAS unsigned char* ic = img + (32 * ct + c) * 128;
          { f32x16 o = MFMA32(__builtin_bit_cast(bf16x8, cur.aq[0]), Ba, zero); o = MFMA32(__builtin_bit_cast(bf16x8, cur.aq[1]), Bb, o);
            if ((w & 1) == 0) o = MFMA32(pa, bsel, o);
#pragma unroll
            for (int g = 0; g < 4; ++g) *(LAS u32x2*)(ic + ((2 * g + hh + c) & 15) * 8) = (u32x2){cvt_pk_bf16(o[4 * g], o[4 * g + 1]), cvt_pk_bf16(o[4 * g + 2], o[4 * g + 3])}; }
          { f32x16 o = MFMA32(__builtin_bit_cast(bf16x8, cur.aq[2]), Ba, zero); o = MFMA32(__builtin_bit_cast(bf16x8, cur.aq[3]), Bb, o);
            if ((w & 1) == 1) o = MFMA32(pa, bsel, o);
#pragma unroll
            for (int g = 0; g < 4; ++g) *(LAS u32x2*)(ic + ((8 + 2 * g + hh + c) & 15) * 8) = (u32x2){cvt_pk_bf16(o[4 * g], o[4 * g + 1]), cvt_pk_bf16(o[4 * g + 2], o[4 * g + 3])}; } }
        f32x16 U = MFMA32(__builtin_bit_cast(bf16x8, cur.ak[0]), Bv[0], zero);
        U = MFMA32(__builtin_bit_cast(bf16x8, cur.ak[1]), Bv[1], U); U = MFMA32(__builtin_bit_cast(bf16x8, cur.ak[2]), Bv[2], U); U = MFMA32(__builtin_bit_cast(bf16x8, cur.ak[3]), Bv[3], U);
        if (ct == 0) {
            if (more) vnext = *(const u32x4*)(X.vB + (size_t)(n + 1) * (64 * NPROJ * 2));
#pragma unroll
            for (int i = 0; i < 16; ++i) S0[i] = ML ? decay * S0[i] + beta * U[i] : dec[i >> 2][i & 3] * (S0[i] + U[i]);
        } else {
#pragma unroll
            for (int i = 0; i < 16; ++i) S1[i] = ML ? decay * S1[i] + beta * U[i] : dec[i >> 2][i & 3] * (S1[i] + U[i]);
        }
    }
    if (ML && X.slice == 0 && hh == 0) { X.npB[(size_t)n * 256] = nreg; nreg = decay * nreg + beta * cks; }
    if (more) *(LAS u32x4*)(lds + LDS_X0 + ((n + 1) & 1) * 8192 + (X.tid >> 3) * 128 + (X.tid & 7) * 16) = vnext;
    asm volatile("s_waitcnt lgkmcnt(0)" ::: "memory"); __builtin_amdgcn_s_barrier(); asm volatile("" ::: "memory");
    { const int q8 = 2 * w + hh;
#pragma unroll
      for (int ct = 0; ct < 2; ++ct) { f32x4 acc = {0.f, 0.f, 0.f, 0.f};
          const LAS unsigned char* ir = lds + PAR * 65536 + (32 * ct + c) * 128 + ((q8 + c) & 15) * 8;
#pragma unroll
          for (int w2 = 0; w2 < 8; ++w2) { const u32x2 v2 = *(const LAS u32x2*)(ir + w2 * 8192); acc = acc + (f32x4){bflo(v2.x), bfhi(v2.x), bflo(v2.y), bfhi(v2.y)}; }
          bf16_t* op = X.outp + ((size_t)n * 64 + 4 * q8) * 2048 + 32 * ct;
          const unsigned p01 = cvt_pk_bf16(acc[0], acc[1]), p23 = cvt_pk_bf16(acc[2], acc[3]);
          op[0] = (bf16_t)(p01 & 0xffffu); op[2048] = (bf16_t)(p01 >> 16); op[2 * 2048] = (bf16_t)(p23 & 0xffffu); op[3 * 2048] = (bf16_t)(p23 >> 16); } }
}
template <bool ML>
DI void scan2_stream(const Frame& F, const Args& a, int s, int slice2) {
    unsigned char* ws = F.ws;
    const int b = (s >> 2) & 1, h = s & 3, sl = s & 7;
    const size_t T0 = (size_t)b * SEQ;
    ScanCtx X;
    X.lds = F.lds; X.tid = F.tid; X.lane = F.lane; X.w = F.wave; X.c = F.lane & 31; X.hh = F.lane >> 5; X.slice = slice2; X.lo16 = (unsigned)F.lane * 16u;
    const unsigned char* proj = ws + WS_PROJ;
    const int vcol = (ML ? C_VM : C_VG) + h * 512 + 64 * slice2;
    X.outp = (bf16_t*)(ws + (ML ? WS_OUTM : WS_OUTG)) + T0 * 2048 + h * 512 + 64 * slice2 + X.c;
    X.aqB = ws + (ML ? WS_AQM : WS_AQG) + (size_t)sl * NCH * 32768 + X.w * 4096;
    X.akB = ws + (ML ? WS_AKM : WS_AKG) + (size_t)sl * NCH * 32768 + X.w * 4096;
    X.pmB = ws + (ML ? WS_PMM : WS_PMG) + (size_t)sl * NCH * 8192 + ((X.w & 1) * 4 + (X.w >> 1)) * 1024;
    X.decB = ws + WS_DEC + ((size_t)sl * NCH * 256 + 32 * X.w) * 4;
    X.dbB = (const float*)(ws + WS_DB) + (size_t)sl * NCH * 2;
    X.ksB = (const float*)(ws + WS_KSUM) + (size_t)sl * NCH * 256 + 32 * X.w + X.c;
    X.npB = (float*)(ws + WS_NPREV) + (size_t)sl * NCH * 256 + 32 * X.w + X.c;
    X.vB = proj + ((T0 + (F.tid >> 3)) * NPROJ + vcol + 8 * (F.tid & 7)) * 2;
    X.vaddr = (unsigned)(size_t)(F.lds + LDS_X0) + (8 * X.hh + ((F.lane & 15) >> 2)) * 128 + 32 * ((F.lane >> 4) & 1) + 8 * (F.lane & 3);
    X.pfA = nullptr; X.pfV = nullptr; X.pfAstep = 0;
    f32x16 S0, S1;
#pragma unroll
    for (int i = 0; i < 16; ++i) { S0[i] = 0.f; S1[i] = 0.f; }
    float nreg = 0.f;
    Scan2Ops A, B;
    scan2_load<ML>(X, A, 0);
    { const u32x4 v0 = *(const u32x4*)X.vB; *(LAS u32x4*)(F.lds + LDS_X0 + (F.tid >> 3) * 128 + (F.tid & 7) * 16) = v0; }
    __syncthreads();
    for (int n = 0; n < NCH; n += 2) {
        scan2_step<ML, 0>(X, A, B, S0, S1, nreg, n);
        scan2_step<ML, 1>(X, B, A, S0, S1, nreg, n + 1);
    }
    __syncthreads();
}

DI void post_fetch(const Frame& F, int t, int i, u32x4 (&ov)[4], u32x4 (&gv)[4]) {
    const int row = t >> 1, ml = (t ^ i) & 1, lane = F.lane;
    const bf16_t* op = (const bf16_t*)(F.ws + (ml ? WS_OUTM : WS_OUTG)) + (size_t)row * 2048 + 8 * lane;
    const bf16_t* gp = (const bf16_t*)(F.ws + WS_PROJ) + (size_t)row * NPROJ + (ml ? C_OM : C_GG) + 8 * lane;
#pragma unroll
    for (int h = 0; h < 4; ++h) { ov[h] = __builtin_nontemporal_load((const u32x4*)(op + h * 512)); gv[h] = __builtin_nontemporal_load((const u32x4*)(gp + h * 512)); }
}
DI void post_pass(const Frame& F, const Args& a, int wi, int nwg, int t0, int t1) {
    unsigned char* ws = F.ws; const int lane = F.lane;
    const int gw = wi * NWAVES + F.wave, NGW = nwg * NWAVES;
    bf16_t* mixed = (bf16_t*)(ws + WS_MIXED);
    u32x4 ov[4], gv[4];
    if (t0 + gw < t1) post_fetch(F, t0 + gw, 0, ov, gv);
    for (int task = t0 + gw, it = 0; task < t1; task += NGW, ++it) {
        const int row = task >> 1, ml = (task ^ it) & 1;
        const float* ng = a.in[ml ? IN_MNORM : IN_GNORM] + 8 * lane;
        f32x4 n0[4], n1[4];
#pragma unroll
        for (int h = 0; h < 4; ++h) { n0[h] = *(const f32x4*)(ng + h * 512); n1[h] = *(const f32x4*)(ng + h * 512 + 4); }
        float inv[4] = {1.f, 1.f, 1.f, 1.f};
        float Xx[4], rr[4]; u32x4 qv[4]; f32x4 na[4], nb[4];
        if (ml) {
            const int b = row >> 13, tl = row & (SEQ - 1), n = tl >> 6, tt = tl & 63, tb = tt >> 5, r = tt & 31;
            const int w = (lane & 31) >> 2, ks = (lane >> 1) & 1, hh = lane & 1;
#pragma unroll
            for (int h = 0; h < 4; ++h) { const int sl = b * 4 + h;
                Xx[h] = vloadf((const float*)(ws + WS_EGX) + (size_t)sl * 3 * SEQ + 2 * SEQ + tl); rr[h] = vloadf((const float*)(ws + WS_RP) + (size_t)sl * SEQ + tl);
                qv[h] = *((const u32x4*)(ws + WS_AQM) + ((size_t)sl * NCH + n) * 2048 + w * 256 + (tb * 2 + ks) * 64 + r + 32 * hh);
                const float* np = (const float*)(ws + WS_NPREV) + ((size_t)sl * NCH + n) * 256 + 32 * w + 16 * ks + 4 * hh; na[h] = *(const f32x4*)np; nb[h] = *(const f32x4*)(np + 8); }
        }
        u32x4 ovn[4], gvn[4];
        { const int tn = task + NGW; const bool has = tn < t1; post_fetch(F, has ? tn : task, has ? it + 1 : it, ovn, gvn); }
        if (ml) {
#pragma unroll
            for (int h = 0; h < 4; ++h) {
                float part = bflo(qv[h].x) * na[h][0] + bfhi(qv[h].x) * na[h][1] + bflo(qv[h].y) * na[h][2] + bfhi(qv[h].y) * na[h][3] + bflo(qv[h].z) * nb[h][0] + bfhi(qv[h].z) * nb[h][1] + bflo(qv[h].w) * nb[h][2] + bfhi(qv[h].w) * nb[h][3];
                if (lane >= 32) part = 0.f;
                const float den = rr[h] + wave_sum(part); inv[h] = 1.f / fmaxf(fabsf(den), Xx[h]); }
        }
#pragma unroll
        for (int h = 0; h < 4; ++h) {
            float o[8] = {bflo(ov[h].x), bfhi(ov[h].x), bflo(ov[h].y), bfhi(ov[h].y), bflo(ov[h].z), bfhi(ov[h].z), bflo(ov[h].w), bfhi(ov[h].w)};
            const float gt[8] = {bflo(gv[h].x), bfhi(gv[h].x), bflo(gv[h].y), bfhi(gv[h].y), bflo(gv[h].z), bfhi(gv[h].z), bflo(gv[h].w), bfhi(gv[h].w)};
            const float nw[8] = {n0[h][0], n0[h][1], n0[h][2], n0[h][3], n1[h][0], n1[h][1], n1[h][2], n1[h][3]};
            float ss = 0.f;
#pragma unroll
            for (int j = 0; j < 8; ++j) { o[j] *= inv[h]; ss += o[j] * o[j]; }
            const float rn = __builtin_amdgcn_rsqf(wave_sum(ss) * (1.f / 512.f) + EPS);
            float y[8];
#pragma unroll
            for (int j = 0; j < 8; ++j) y[j] = o[j] * rn * nw[j] * (ml ? sigmoidf_(gt[j]) : siluf_(gt[j]));
            u32x4 wv; wv.x = cvt_pk_bf16(y[0], y[1]); wv.y = cvt_pk_bf16(y[2], y[3]); wv.z = cvt_pk_bf16(y[4], y[5]); wv.w = cvt_pk_bf16(y[6], y[7]);
            *(u32x4*)(mixed + (size_t)row * D + ml * 2048 + h * 512 + 8 * lane) = wv; }
#pragma unroll
        for (int h = 0; h < 4; ++h) { ov[h] = ovn[h]; gv[h] = gvn[h]; }
    }
}

DI void final_norm(const Frame& F, const Args& a) {
    const int gw = F.vcu * NWAVES + F.wave, NGW = F.G * NWAVES, lane = F.lane;
    const float* ss3 = (const float*)(F.ws + WS_SS3); const float* g = a.in[IN_NFING]; const bf16_t* hb = (const bf16_t*)(F.ws + WS_HB);
    u32x4 cur[8], nxt[8]; float css, nss = 0.f;
    { const u32x4* p = (const u32x4*)(hb + (size_t)gw * D) + lane;
#pragma unroll
      for (int j = 0; j < 8; ++j) cur[j] = __builtin_nontemporal_load(p + 64 * j);
      css = ss3[(size_t)gw * 64 + lane]; }
    for (int row = gw; row < M; row += NGW) {
        const int nrow = row + NGW; const bool more = nrow < M;
        if (more) { const u32x4* p = (const u32x4*)(hb + (size_t)nrow * D) + lane;
#pragma unroll
            for (int j = 0; j < 8; ++j) nxt[j] = __builtin_nontemporal_load(p + 64 * j);
            nss = ss3[(size_t)nrow * 64 + lane]; }
        const float rstd = __builtin_amdgcn_rsqf(wave_sum(css) * (1.f / D) + EPS);
        float* q = a.out + (size_t)row * D + 8 * lane;
#pragma unroll
        for (int j = 0; j < 8; ++j) { const f32x4 g0 = *(const f32x4*)(g + 512 * j + 8 * lane), g1 = *(const f32x4*)(g + 512 * j + 8 * lane + 4); const u32x4 w = cur[j];
            *(f32x4*)(q + 512 * j) = (f32x4){bflo(w.x), bfhi(w.x), bflo(w.y), bfhi(w.y)} * rstd * g0; *(f32x4*)(q + 512 * j + 4) = (f32x4){bflo(w.z), bfhi(w.z), bflo(w.w), bfhi(w.w)} * rstd * g1; }
#pragma unroll
        for (int j = 0; j < 8; ++j) cur[j] = nxt[j];
        css = nss;
    }
}

struct SchedStd {
    int nM, nN, G, c, lda, ldb; size_t a0, b0, bbatch;
    DI bool next(int i, pg8::Unit& u) const { int pm, pn; if (!pg8::static_tile(i, G, c, nM, nN, pm, pn)) return false;
        u.pm = pm; u.pn = pn; u.z = 0; u.ldc = 0; u.coff = 0; u.aoff = a0 + (size_t)pm * 256 * lda; u.boff = b0 + (size_t)(pm >> 5) * bbatch + (size_t)pn * 256 * ldb; return true; }
};
struct SchedG1 : SchedStd {
    DI bool next(int i, pg8::Unit& u) const { if (!SchedStd::next(i, u)) return false; u.ldc = NPROJ; u.coff = WS_PROJ / 2 + (size_t)u.pm * 256 * NPROJ + (size_t)u.pn * 256; return true; }
};
struct SchedRowMajor {
    int G, c; size_t a0, b0;
    DI bool next(int i, pg8::Unit& u) const { if (i >= 4 || G != 256) return false; const int x = c & 7, j = c >> 3, pm = 16 * i + 2 * x + (j >> 4), pn = j & 15;
        u.pm = pm; u.pn = pn; u.z = 0; u.ldc = 0; u.coff = 0; u.aoff = a0 + (size_t)pm * 256 * FF; u.boff = b0 + (size_t)pn * 256 * FF; return true; }
};
struct SchedKV {
    int G, c;
    DI bool next(int i, pg8::Unit& u) const { const int L = i * G + c; if (L >= 64) return false; const int which = L >> 5, pm = (L >> 4) & 1, pn = L & 15;
        u.pm = pm; u.pn = pn; u.z = which; u.ldc = D; u.aoff = WS_MEMN / 2 + (size_t)pm * 256 * D; u.boff = (which ? WS_WV : WS_WK) / 2 + (size_t)pn * 256 * D;
        u.coff = (which ? WS_VB : WS_KB) / 2 + (size_t)pm * 256 * D + (size_t)pn * 256; return true; }
};
struct SchedX {
    int G, c;
    DI bool next(int i, pg8::Unit& u) const { const int L = i * G + c; if (L >= 256) return false; const int Lq = L & 127, b = Lq >> 6, h = (Lq >> 4) & 3, p = Lq & 15;
        u.z = L >> 7;
        if (L < 128) { u.pm = 0; u.pn = p; u.ldc = D; u.aoff = WS_KB / 2 + (size_t)b * 256 * D + h * 1024; u.boff = WS_WQ / 2 + (size_t)p * 256 * D + h * 1024;
            u.coff = WS_WQK / 2 + ((size_t)b * 1024 + h * 256) * D + (size_t)p * 256; }
        else { u.pm = 0; u.pn = 0; u.ldc = 1024; u.aoff = WS_WO / 2 + (size_t)p * 256 * D + h * 1024; u.boff = WS_VB / 2 + (size_t)b * 256 * D + h * 1024;
            u.coff = WS_VW / 2 + ((size_t)b * D + (size_t)p * 256) * 1024 + h * 256; }
        return true; }
};
struct SchedScore {
    int vcu;
    DI bool next(int i, pg8::Unit& u) const { if (i > 0 || vcu >= 256) return false; const int pm = vcu >> 2, hd = vcu & 3;
        u.pm = pm; u.pn = hd; u.z = 0; u.ldc = 1024; u.coff = 0; u.aoff = WS_HB / 2 + (size_t)pm * 256 * D; u.boff = WS_WQK / 2 + ((size_t)(pm >> 5) * 1024 + hd * 256) * D; return true; }
};

__global__ void __launch_bounds__(NWAVES * 64, 2) fwd_kernel(Args args) {
    extern __shared__ __attribute__((aligned(16))) unsigned char lds_raw[];
    Frame F;
    F.lds = (LAS unsigned char*)lds_raw; F.ws = args.ws;
    F.tid = threadIdx.x; F.lane = F.tid & 63; F.wave = __builtin_amdgcn_readfirstlane(F.tid >> 6);
    F.G = gridDim.x; F.bx = blockIdx.x; F.vcu = (F.G % 8 == 0) ? (F.bx % 8) * (F.G / 8) + F.bx / 8 : F.bx;
    volatile LAS unsigned* MISC = (volatile LAS unsigned*)(F.lds + MISC_OFF);
    for (int u = F.tid; u < (LDS_BYTES - LDSCTL_OFF) / 4; u += NWAVES * 64) ((LAS unsigned*)(F.lds + LDSCTL_OFF))[u] = 0u;
    __syncthreads();
    gu32* ctl = (gu32*)(args.ws + WS_CTL);
    XcdBarrier bar = xcd_barrier_post((unsigned*)(ctl + CW_BAR), MISC + 8);
    const int lo = args.ph_lo, hi = args.ph_hi;
#define IN(k) (lo <= (k) && (k) < hi)
#define SEAM(k) do { if (IN(k) && IN((k) + 1)) xcd_barrier(bar); } while (0)
    const bf16_t* wsb = (const bf16_t*)args.ws;
    float* ss1 = (float*)(args.ws + WS_SS1); float* ss2 = (float*)(args.ws + WS_SS2); float* ss3 = (float*)(args.ws + WS_SS3);
#define PH0 { p0a_weights(F, args); }
#define PH1 { p0b_x(F, args); }
#define PH2 { pg8::Gemm g{wsb, D, D, D}; SchedKV S{F.G, F.bx}; pg8::EpiBf16 E{(bf16_t*)args.ws, nullptr, nullptr}; \
        pg8::gemm_phase<pg8::EpiBf16, SchedKV, true>(F.lds, g, S, E); }
#define PH3 { pg8::Gemm g{wsb, D, D, D}; SchedG1 S; S.nM = 64; S.nN = 48; S.G = F.G; S.c = F.bx; S.lda = D; S.ldb = D; S.a0 = (size_t)(((const char*)args.out - (const char*)args.ws) / 2); S.b0 = WS_WIN / 2; S.bbatch = 0; \
        LAS float* rl = (LAS float*)(F.lds + LDS_X1); \
        { pg8::Unit u0; if (S.next(0, u0) && F.tid < 256) rl[F.tid] = ((const float*)(args.ws + WS_RSTD0))[u0.pm * 256 + F.tid]; __syncthreads(); } \
        pg8::EpiBf16 E{(bf16_t*)args.ws, rl, nullptr}; \
        pg8::gemm_phase<pg8::EpiBf16, SchedG1, true>(F.lds, g, S, E); \
        if (F.vcu < 8) gate_scan(F, args, F.vcu); }
#define PH4 { pg8::Gemm g{wsb, D, D, 1024}; SchedX S{F.G, F.bx}; pg8::EpiBf16 E{(bf16_t*)args.ws, nullptr, nullptr}; \
        pg8::gemm_phase<pg8::EpiBf16, SchedX, true>(F.lds, g, S, E); }
#define PH5 { u32x4 pq[4], pk[4]; if (F.vcu < 2048) pre_fetch(F, F.vcu, pq, pk); for (int it = F.vcu; it < 2048; it += F.G) { const int s = it >> 7, n = it & 127, nx = (it + F.G < 2048) ? it + F.G : it; if (s < 8) pre_item<false>(F, args, s, n, pq, pk, nx); else pre_item<true>(F, args, s, n, pq, pk, nx); } }
#define PH6 { const int xg = F.bx & 7, j = F.bx >> 3;         \
        if (j < 16) { const int s = 2 * xg + (j >> 3), slice2 = j & 7; if (s < 8) scan2_stream<false>(F, args, s, slice2); else scan2_stream<true>(F, args, s, slice2); } \
        p0a_rest(F, args); }
#define PH7 { if (F.bx < 64) { pg8::Gemm g{wsb, D, D, D}; SchedKV S{F.G, F.bx}; pg8::EpiBf16 E{(bf16_t*)args.ws, nullptr, nullptr}; \
            pg8::gemm_phase<pg8::EpiBf16, SchedKV, true>(F.lds, g, S, E); } \
        else post_pass(F, args, F.bx - 64, F.G - 64, 0, M * 2); }
#define PH8 { pg8::Gemm g{wsb, D, D, D}; SchedStd S{64, 16, F.G, F.bx, D, D, WS_MIXED / 2, WS_WOUT / 2, 0}; \
        pg8::EpiResid<true> E{args.out, (bf16_t*)(args.ws + WS_HB), ss1, nullptr}; \
        pg8::gemm_phase<pg8::EpiResid<true>, SchedStd, true>(F.lds, g, S, E); }
#define PH9 { pg8::Gemm g{wsb, D, D, D}; SchedScore S{F.vcu}; pg8::EpiSoftmax E{(bf16_t*)(args.ws + WS_P), ss1}; \
        pg8::gemm_phase<pg8::EpiSoftmax, SchedScore, false>(F.lds, g, S, E); }
#define PH10 { pg8::Gemm g{wsb, 1024, 1024, 1024}; SchedStd S{64, 16, F.G, F.bx, 1024, 1024, WS_P / 2, WS_VW / 2, (size_t)D * 1024}; \
        pg8::EpiResid<true> E{args.ws + WS_HB, (bf16_t*)(args.ws + WS_MIXED), ss2, nullptr}; \
        pg8::gemm_phase<pg8::EpiResid<true>, SchedStd, true>(F.lds, g, S, E); }
#define PH11 { pg8::Gemm g{wsb, D, D, D}; SchedStd S{64, 86, F.G, F.bx, D, D, WS_MIXED / 2, WS_WGU / 2, 0}; \
        LAS float* rl = (LAS float*)(F.lds + LDS_X1); \
        { pg8::Unit u0; if (S.next(0, u0) && F.tid < 256) { const f32x4* pp = (const f32x4*)(ss2 + (size_t)(u0.pm * 256 + F.tid) * 64); float sq = 0.f; \
            _Pragma("unroll") for (int j = 0; j < 16; ++j) { const f32x4 t4 = pp[j]; sq += (t4[0] + t4[1]) + (t4[2] + t4[3]); } \
            rl[F.tid] = __builtin_amdgcn_rsqf(sq * (1.0f / D) + EPS); } __syncthreads(); } \
        pg8::EpiSwiglu E{(bf16_t*)(args.ws + WS_ACT), rl}; \
        pg8::gemm_phase<pg8::EpiSwiglu, SchedStd, true>(F.lds, g, S, E); }
#define PH12 { pg8::Gemm g{wsb, FF, FF, FF}; SchedRowMajor S{F.G, F.bx, WS_ACT / 2, WS_WDN / 2}; \
        pg8::EpiResid<true> E{args.ws + WS_MIXED, (bf16_t*)(args.ws + WS_HB), ss3, nullptr}; \
        pg8::gemm_phase<pg8::EpiResid<true>, SchedRowMajor, true>(F.lds, g, S, E); }
#define PH13 { final_norm(F, args); }
#ifndef REP_PHASE
#define REP_PHASE -1
#endif
#ifdef PROBE_TIME
#define TSTAMP(k) do { if (F.bx == 0 && F.tid == 0) MISC[16 + (k)] = (unsigned)__builtin_amdgcn_s_memrealtime(); } while (0)
#else
#define TSTAMP(k) do {} while (0)
#endif
#define RUN(k, body) TSTAMP(k); if (IN(k)) body SEAM(k);
#ifdef PROBE_SLEEP_US
#define PHSLEEP { const unsigned long long t0 = __builtin_amdgcn_s_memrealtime(); while (__builtin_amdgcn_s_memrealtime() - t0 < (unsigned long long)(PROBE_SLEEP_US) * 100ull) __builtin_amdgcn_s_sleep(32); }
#else
#define PHSLEEP {}
#endif
    RUN(0, PH0) RUN(1, PH1) RUN(2, PH3) RUN(3, PH5) RUN(4, PH6) RUN(5, PH7) RUN(6, PH4) RUN(7, PH8) RUN(8, PH9) RUN(9, PH10) RUN(10, PH11) RUN(11, PH12)
    TSTAMP(12);
    if (IN(12)) PH13
#ifdef PROBE_TIME
    TSTAMP(13);
    if (F.bx == 0 && F.tid == 0) { asm volatile("s_waitcnt vmcnt(0)" ::: "memory"); args.out[0] += (float)(MISC[16 + PROBE_TIME + 1] - MISC[16 + PROBE_TIME]) * 0.01f * PROBE_SCALE; }
#endif
#ifdef PROBE_STREAM
    if (IN(14)) {
        const int gw = F.vcu * NWAVES + F.wave, NGW = F.G * NWAVES; float* dead = (float*)(args.ws + WS_P);
        for (int row = gw; row < M; row += NGW) { const f32x4* p = (const f32x4*)(args.in[IN_X] + (size_t)row * D) + F.lane; f32x4 acc = {0.f, 0.f, 0.f, 0.f};
#pragma unroll
            for (int j = 0; j < 16; ++j) acc = acc + p[64 * j];
            const float t = wave_sum(acc[0] + acc[1] + acc[2] + acc[3]); if (F.lane == 0) dead[row] = t; }
    }
    if (IN(15)) {
        const int gw = F.vcu * NWAVES + F.wave, NGW = F.G * NWAVES; float* dead = (float*)(args.ws + WS_PROJ);
        for (int row = gw; row < M; row += NGW) { const f32x4* p = (const f32x4*)(args.in[IN_X] + (size_t)row * D) + F.lane; f32x4* q = (f32x4*)(dead + (size_t)row * D) + F.lane; f32x4 v[16];
#pragma unroll
            for (int j = 0; j < 16; ++j) v[j] = p[64 * j];
#pragma unroll
            for (int j = 0; j < 16; ++j) q[64 * j] = v[j]; }
    }
#endif
#undef IN
#undef SEAM
}

#ifdef DIAG_REPRO
__global__ void ck_kernel(const unsigned* buf, int rows, int words_per_row, unsigned* sig) {
    const int gw = (blockIdx.x * blockDim.x + threadIdx.x) >> 6, lane = threadIdx.x & 63, nw = (gridDim.x * blockDim.x) >> 6;
    for (int r = gw; r < rows; r += nw) { unsigned x = 0u; const unsigned* p = buf + (size_t)r * words_per_row;
        for (int i = lane; i < words_per_row; i += 64) x ^= p[i] * 2654435761u + (unsigned)i;
        for (int o = 1; o < 64; o <<= 1) x ^= __shfl_xor(x, o);
        if (lane == 0) sig[r] = x; }
}
__global__ void cmp_kernel(const unsigned* s0, const unsigned* s1, int rows, float* out) {
    if (blockIdx.x == 0 && threadIdx.x == 0) { int cnt = 0; for (int r = 0; r < rows; ++r) cnt += (s0[r] != s1[r]); out[0] += cnt ? 0.75f : 0.25f; }
}
#endif
#ifndef MK_PER_PHASE
#define MK_PER_PHASE 0
#endif
constexpr int NPHASES = 13;
extern "C" void kernel_launch(void* const* d_in, const int* in_sizes, int n_in, void* d_out, int out_size, void* d_ws, size_t ws_size, hipStream_t stream) {
    static int grid = 0;
    if (grid == 0) {
        if (n_in != 24 || in_sizes[0] != M * D || out_size != M * D || ws_size < WS_END) {
            fprintf(stderr, "kernel_launch: unexpected problem (n_in %d, in0 %d, out %d, ws %zu < %zu); nothing launched\n", n_in, n_in > 0 ? in_sizes[0] : -1, out_size, ws_size, (size_t)WS_END); grid = -1; return; }
        int dev = 0, cus = 0, per_cu = 0;
        if (hipGetDevice(&dev) != hipSuccess || hipDeviceGetAttribute(&cus, hipDeviceAttributeMultiprocessorCount, dev) != hipSuccess) { grid = -1; return; }
        if (hipFuncSetAttribute((const void*)fwd_kernel, hipFuncAttributeMaxDynamicSharedMemorySize, LDS_BYTES) != hipSuccess) { fprintf(stderr, "kernel_launch: hipFuncSetAttribute failed\n"); grid = -1; return; }
        if (hipOccupancyMaxActiveBlocksPerMultiprocessor(&per_cu, (const void*)fwd_kernel, NWAVES * 64, LDS_BYTES) != hipSuccess || per_cu < 1)
            fprintf(stderr, "kernel_launch: occupancy query reports %d workgroups per CU\n", per_cu);
        (void)hipGetLastError();
        grid = cus < 256 ? cus : 256;
        if (grid != 256) fprintf(stderr, "kernel_launch: %d CUs; this kernel is built for 256\n", cus);
    }
    if (grid < 0) return;
    if (hipMemsetAsync((char*)d_ws + WS_CTL, 0, CTL_ZERO_BYTES, stream) != hipSuccess) return;
    Args a{};
    for (int i = 0; i < 24; ++i) a.in[i] = (const float*)d_in[i];
    a.out = (float*)d_out; a.ws = (unsigned char*)d_ws;
#if MK_PER_PHASE
    for (int p = 0; p < NPHASES; ++p) { a.ph_lo = p; a.ph_hi = p + 1; hipLaunchKernelGGL(fwd_kernel, dim3(grid), dim3(NWAVES * 64), LDS_BYTES, stream, a); }
#else
    a.ph_lo = 0; a.ph_hi = NPHASES;
    hipLaunchKernelGGL(fwd_kernel, dim3(grid), dim3(NWAVES * 64), LDS_BYTES, stream, a);
#endif
#ifdef DIAG_REPRO
    { unsigned* sig0 = (unsigned*)((char*)d_ws + 1220 * MiB); unsigned* sig1 = sig0 + 65536;
      hipLaunchKernelGGL(ck_kernel, dim3(256), dim3(256), 0, stream, (const unsigned*)d_out, M, D, sig0);
      (void)hipMemsetAsync((char*)d_ws + WS_CTL, 0, CTL_ZERO_BYTES, stream);
      hipLaunchKernelGGL(fwd_kernel, dim3(grid), dim3(NWAVES * 64), LDS_BYTES, stream, a);
      hipLaunchKernelGGL(ck_kernel, dim3(256), dim3(256), 0, stream, (const unsigned*)d_out, M, D, sig1);
      hipLaunchKernelGGL(cmp_kernel, dim3(1), dim3(64), 0, stream, (const unsigned*)sig0, (const unsigned*)sig1, M, (float*)d_out); }
#endif
#ifdef PROBE_EXTRA
    { const int extra[] = PROBE_EXTRA; for (int p : extra) { a.ph_lo = p; a.ph_hi = p + 1; hipLaunchKernelGGL(fwd_kernel, dim3(grid), dim3(NWAVES * 64), LDS_BYTES, stream, a); } }
#endif
    const hipError_t le = hipPeekAtLastError();
    if (le != hipSuccess) fprintf(stderr, "kernel_launch: launch failed: %s\n", hipGetErrorName(le));
}
```

```cpp
#include <hip/hip_runtime.h>
#include <cstdio>
#include <cstdint>

#define LAS __attribute__((address_space(3)))
#define GAS __attribute__((address_space(1)))
typedef unsigned short bf16_t;
typedef short bf16x8 __attribute__((ext_vector_type(8)));
typedef float f32x4 __attribute__((ext_vector_type(4)));
typedef float f32x2 __attribute__((ext_vector_type(2)));
typedef float f32x16 __attribute__((ext_vector_type(16)));
typedef unsigned u32x4 __attribute__((ext_vector_type(4)));
typedef unsigned u32x2 __attribute__((ext_vector_type(2)));
typedef GAS unsigned gu32;
#define RLX_AGENT __ATOMIC_RELAXED, __HIP_MEMORY_SCOPE_AGENT
#define DI __device__ __forceinline__

constexpr int D = 4096, SEQ = 8192, M = 16384, NPROJ = 12288, INCOLS = 12312, FF = 11008, NCH = 128;
constexpr float EPS = 1e-6f;
constexpr int C_QG = 0, C_KG = 1024, C_VG = 2048, C_GG = 4096, C_QM = 6144, C_KM = 7168, C_VM = 8192, C_OM = 10240;

constexpr size_t MiB = 1u << 20;
constexpr size_t WS_CTL = 0, CTL_ZERO_BYTES = 1 * MiB;
constexpr size_t WS_RSTD0 = 1 * MiB;
constexpr size_t WS_SMALLP = 2 * MiB;
constexpr size_t WS_SS1 = 4 * MiB, WS_SS2 = 8 * MiB, WS_SS3 = 12 * MiB;
constexpr size_t WS_WSMALL = 16 * MiB;
constexpr size_t WS_MEMN = 17 * MiB;
constexpr size_t WS_KB = 24 * MiB, WS_VB = 28 * MiB;
constexpr size_t WS_WQK = 32 * MiB;
constexpr size_t WS_VW = 48 * MiB;
constexpr size_t WS_WOUT = 64 * MiB, WS_WQ = 96 * MiB, WS_WK = 128 * MiB, WS_WV = 160 * MiB, WS_WO = 192 * MiB;
constexpr size_t WS_WGU = 224 * MiB;
constexpr size_t WS_WDN = 396 * MiB;
constexpr size_t WS_WIN = 482 * MiB;
constexpr size_t WS_XB = 578 * MiB;
constexpr size_t WS_DEC = 482 * MiB;
constexpr size_t WS_KSUM = 484 * MiB;
constexpr size_t WS_NPREV = 485 * MiB;
constexpr size_t WS_EGX = 21 * MiB;
constexpr size_t WS_RP = 483 * MiB;
constexpr size_t WS_DB = 22 * MiB;
constexpr size_t WS_AQM = 490 * MiB, WS_AQG = 522 * MiB, WS_AKG = 554 * MiB, WS_AKM = 586 * MiB;
constexpr size_t WS_PMG = 618 * MiB, WS_PMM = 626 * MiB;
constexpr size_t WS_MIXED = 522 * MiB;
constexpr size_t WS_P = 650 * MiB;
constexpr size_t WS_PROJ = 706 * MiB;
constexpr size_t WS_ACT = 706 * MiB;
constexpr size_t WS_OUTG = 1090 * MiB, WS_OUTM = 1154 * MiB;
constexpr size_t WS_HB = 1090 * MiB;
constexpr size_t WS_END = 1218 * MiB;

constexpr int CW_TMO = 0, CW_CODE = 1, CW_BAR = 4096;

constexpr int RING_BYTES = 131072;
constexpr int LDS_X0 = RING_BYTES;
constexpr int LDS_X1 = RING_BYTES + 16384;
constexpr int LDSCTL_OFF = RING_BYTES + 20480, MISC_OFF = LDSCTL_OFF + 64;
constexpr int LDS_BYTES = 155648;
constexpr int NWAVES = 8;

typedef __bf16 bf16x2_t __attribute__((ext_vector_type(2)));
DI unsigned cvt_pk_bf16(float lo, float hi) { const f32x2 v = {lo, hi}; return __builtin_bit_cast(unsigned, __builtin_convertvector(v, bf16x2_t)); }
DI unsigned f2bf(float f) { return (unsigned)__builtin_bit_cast(unsigned short, (__bf16)f); }
DI unsigned pk2(float lo, float hi) { return cvt_pk_bf16(lo, hi); }
DI float bf2f(unsigned short b) { return __builtin_bit_cast(float, ((unsigned)b) << 16); }
DI float bflo(unsigned w) { return __builtin_bit_cast(float, w << 16); }
DI float bfhi(unsigned w) { return __builtin_bit_cast(float, w & 0xffff0000u); }
DI float wave_sum(float v) {
#pragma unroll
    for (int o = 1; o < 64; o <<= 1) v += __shfl_xor(v, o);
    return v;
}
DI float logsigmoidf(float x) { return fminf(x, 0.f) - __logf(1.f + __expf(-fabsf(x))); }
DI float sigmoidf_(float x) { return 1.f / (1.f + __expf(-x)); }
DI float siluf_(float x) { return x / (1.f + __expf(-x)); }
DI float vloadf(const float* p) { return __builtin_bit_cast(float, __hip_atomic_load((const unsigned*)p, RLX_AGENT)); }

namespace pg8 {
constexpr int BM = 256, BK = 64, HALF = 128, HTB = HALF * BK * 2, STAGE_BYTES = 8 * HTB, NXCD = 8, WGM = 8;
__host__ __device__ __forceinline__ int lds_byte(int r, int c) { const int st = (r >> 4) * 2 + (c >> 5), rr = r & 15, cc = c & 31, ob = rr * 64 + cc * 2; return st * 1024 + (ob ^ (((ob >> 9) & 1) << 5)); }
__host__ __device__ __forceinline__ void stage_rc(int b, int& R, int& C) { const int st = b / 1024, sb = b % 1024, swz = sb ^ (((sb >> 9) & 1) << 5); R = (st >> 1) * 16 + swz / 64; C = (st & 1) * 32 + (swz % 64) / 2; }
__host__ __device__ __forceinline__ int perm32(int rho) { const int n = rho >> 4, i = rho & 15; return 8 * (i >> 2) + 4 * n + (i & 3); }

struct Unit { int pm, pn, ldc, z; size_t aoff, boff, coff; };
struct Gemm { const bf16_t* base; int lda, ldb, K; };

DI bool static_tile(int i, int G, int c, int nM, int nN, int& pm, int& pn) {
    const int nwg = nM * nN; const long L = (long)i * G + c; if (L >= nwg) return false;
    int wgid = (int)L; { const int q = nwg / NXCD, r = nwg % NXCD, xcd = wgid % NXCD, off = wgid / NXCD; wgid = (xcd < r ? xcd * (q + 1) : r * (q + 1) + (xcd - r) * q) + off; }
    const int nig = WGM * nN, gid = wgid / nig, fm = gid * WGM, gsz = (nM - fm) < WGM ? (nM - fm) : WGM;
    pm = fm + ((wgid % nig) % gsz); pn = (wgid % nig) / gsz; return true;
}
#ifndef PG8_SP2
#define PG8_SP2 true
#endif
template <class Epi, class Sched, bool ALIGN_EPI, bool SP2 = PG8_SP2>
DI void gemm_phase(LAS unsigned char* lds, const Gemm g, const Sched& S, const Epi& E) {
    const int tid = threadIdx.x, wid = __builtin_amdgcn_readfirstlane(tid >> 6), lane = tid & 63, wr = wid >> 2, wc = wid & 3, fr = lane & 15, fq = lane >> 4;
    const int K = g.K, nt = K / BK;
    unsigned voffA[2], voffB[2];
#pragma unroll
    for (int i = 0; i < 2; ++i) { int R, C; stage_rc(tid * 16 + i * 8192, R, C); const int Rb = (R & ~31) + perm32(R & 31);
        voffA[i] = (unsigned)(R * g.lda + C) * 2u; voffB[i] = (unsigned)(Rb * g.ldb + C) * 2u; }
    const size_t kstep = (size_t)(BK * 2);
    const size_t hstepA = (size_t)HALF * g.lda * 2, hstepB = (size_t)HALF * g.ldb * 2;
    const unsigned ldsw = (unsigned)wid * 1024u;
    const int aoff = lds_byte(wr * 64 + fr, fq * 8), boff = lds_byte(wc * 32 + fr, fq * 8);
#define PG8_SA(b, h) (((b) * 2 + (h)) * HTB)
#define PG8_SB(b, h) ((4 + (b) * 2 + (h)) * HTB)
#define PG8_STAGE(bufoff, gbase, voff) do { _Pragma("unroll") for (int _i = 0; _i < 2; ++_i) \
        __builtin_amdgcn_global_load_lds((const unsigned*)((const char*)(gbase) + (voff)[_i]), (LAS unsigned*)(lds + (bufoff) + ldsw + _i * 8192), 16, 0, 0); } while (0)
#define PG8_LDA(dst, b, h) do { _Pragma("unroll") for (int m = 0; m < 4; ++m) _Pragma("unroll") for (int k = 0; k < 2; ++k) dst[m][k] = *(const LAS bf16x8*)(lds + PG8_SA(b, h) + aoff + m * 2048 + k * 1024); } while (0)
#define PG8_LDB(dst, b, h) do { _Pragma("unroll") for (int n = 0; n < 2; ++n) _Pragma("unroll") for (int k = 0; k < 2; ++k) dst[n][k] = *(const LAS bf16x8*)(lds + PG8_SB(b, h) + boff + n * 2048 + k * 1024); } while (0)
#define PG8_MMA(ai, bj, At, Bt) do { __builtin_amdgcn_s_setprio(1); _Pragma("unroll") for (int m = 0; m < 4; ++m) _Pragma("unroll") for (int n = 0; n < 2; ++n) _Pragma("unroll") for (int k = 0; k < 2; ++k) \
        acc[ai][bj][m][n] = __builtin_amdgcn_mfma_f32_16x16x32_bf16(Bt[n][k], At[m][k], acc[ai][bj][m][n], 0, 0, 0); __builtin_amdgcn_s_setprio(0); } while (0)
#define PG8_WAIT_V(n) asm volatile("s_waitcnt vmcnt(" #n ")" ::: "memory")
#define PG8_WAIT_L(n) asm volatile("s_waitcnt lgkmcnt(" #n ")" ::: "memory")
#define PG8_BAR __builtin_amdgcn_s_barrier()
#define PG8_SCHED __builtin_amdgcn_sched_barrier(0)
    Unit cur, nxt; int ui = 0;
    if (!S.next(0, cur)) return;
    f32x4 acc[2][2][4][2];
#pragma unroll
    for (int a = 0; a < 2; ++a)
#pragma unroll
        for (int b = 0; b < 2; ++b)
#pragma unroll
            for (int m = 0; m < 4; ++m)
#pragma unroll
                for (int n = 0; n < 2; ++n) acc[a][b][m][n] = (f32x4){0.f, 0.f, 0.f, 0.f};
    bf16x8 At[4][2], B0[2][2], B1[2][2];
    const char* cA = (const char*)(g.base + cur.aoff); const char* cB = (const char*)(g.base + cur.boff);
    if constexpr (SP2) {
    PG8_STAGE(PG8_SB(0, 0), cB, voffB); PG8_STAGE(PG8_SB(0, 1), cB + hstepB, voffB); PG8_STAGE(PG8_SA(0, 0), cA, voffA); PG8_STAGE(PG8_SA(0, 1), cA + hstepA, voffA);
    if (wr == 1) PG8_BAR;
    PG8_WAIT_V(2); PG8_BAR;
    PG8_STAGE(PG8_SB(1, 0), cB + kstep, voffB); PG8_STAGE(PG8_SA(1, 0), cA + kstep, voffA); PG8_STAGE(PG8_SB(1, 1), cB + hstepB + kstep, voffB);
    PG8_WAIT_V(6); PG8_BAR;
    } else {
    PG8_STAGE(PG8_SB(0, 0), cB, voffB); PG8_STAGE(PG8_SA(0, 0), cA, voffA); PG8_STAGE(PG8_SB(0, 1), cB + hstepB, voffB); PG8_STAGE(PG8_SA(0, 1), cA + hstepA, voffA);
    if (wr == 1) PG8_BAR;
    PG8_WAIT_V(4); PG8_BAR;
    PG8_STAGE(PG8_SB(1, 0), cB + kstep, voffB); PG8_STAGE(PG8_SA(1, 0), cA + kstep, voffA); PG8_STAGE(PG8_SB(1, 1), cB + hstepB + kstep, voffB);
    PG8_WAIT_V(6); PG8_BAR;
    }
    for (;;) {
        const bool has_next = S.next(ui + 1, nxt);
        const char* nA = has_next ? (const char*)(g.base + nxt.aoff) : cA; const char* nB = has_next ? (const char*)(g.base + nxt.boff) : cB;
        for (int t = 0; t < nt; t += 2) {
            const bool last = (t == nt - 2);
            const char* a1 = cA + (size_t)(t + 1) * kstep;
            const char* a2 = last ? nA : cA + (size_t)(t + 2) * kstep; const char* b2 = last ? nB : cB + (size_t)(t + 2) * kstep;
            const char* a3 = a2 + kstep; const char* b3 = b2 + kstep;
            if constexpr (SP2) {
            PG8_LDB(B0, 0, 0); PG8_LDB(B1, 0, 1); PG8_SCHED; PG8_LDA(At, 0, 0); PG8_STAGE(PG8_SA(1, 1), a1 + hstepA, voffA);
            PG8_WAIT_V(8); PG8_WAIT_L(0); PG8_BAR; PG8_MMA(0, 0, At, B0); PG8_MMA(0, 1, At, B1); PG8_BAR; PG8_SCHED;
            PG8_LDA(At, 0, 1); PG8_STAGE(PG8_SB(0, 0), b2, voffB); PG8_STAGE(PG8_SB(0, 1), b2 + hstepB, voffB); PG8_STAGE(PG8_SA(0, 0), a2, voffA);
            PG8_WAIT_V(8); PG8_WAIT_L(0); PG8_BAR; PG8_MMA(1, 0, At, B0); PG8_MMA(1, 1, At, B1); PG8_BAR; PG8_SCHED;
            PG8_LDB(B0, 1, 0); PG8_LDB(B1, 1, 1); PG8_SCHED; PG8_LDA(At, 1, 0); PG8_STAGE(PG8_SA(0, 1), a2 + hstepA, voffA);
            PG8_WAIT_V(8); PG8_WAIT_L(0); PG8_BAR; PG8_MMA(0, 0, At, B0); PG8_MMA(0, 1, At, B1); PG8_BAR; PG8_SCHED;
            PG8_LDA(At, 1, 1); PG8_STAGE(PG8_SB(1, 0), b3, voffB); PG8_STAGE(PG8_SB(1, 1), b3 + hstepB, voffB); PG8_STAGE(PG8_SA(1, 0), a3, voffA);
            PG8_WAIT_V(8); PG8_WAIT_L(0); PG8_BAR; PG8_MMA(1, 0, At, B0); PG8_MMA(1, 1, At, B1); PG8_BAR; PG8_SCHED;
            } else {
            PG8_LDB(B0, 0, 0); PG8_SCHED; PG8_LDA(At, 0, 0); PG8_STAGE(PG8_SA(1, 1), a1 + hstepA, voffA);
            PG8_WAIT_L(8); PG8_BAR; PG8_WAIT_L(0); PG8_MMA(0, 0, At, B0); PG8_BAR; PG8_SCHED;
            PG8_LDB(B1, 0, 1); PG8_STAGE(PG8_SB(0, 0), b2, voffB);
            PG8_BAR; PG8_WAIT_L(0); PG8_MMA(0, 1, At, B1); PG8_BAR;
            PG8_LDA(At, 0, 1); PG8_STAGE(PG8_SA(0, 0), a2, voffA);
            PG8_BAR; PG8_WAIT_L(0); PG8_MMA(1, 0, At, B0); PG8_BAR; PG8_SCHED;
            PG8_STAGE(PG8_SB(0, 1), b2 + hstepB, voffB);
            PG8_WAIT_V(6); PG8_BAR; PG8_MMA(1, 1, At, B1); PG8_BAR;
            PG8_LDB(B0, 1, 0); PG8_SCHED; PG8_LDA(At, 1, 0); PG8_STAGE(PG8_SA(0, 1), a2 + hstepA, voffA);
            PG8_WAIT_L(8); PG8_BAR; PG8_WAIT_L(0); PG8_MMA(0, 0, At, B0); PG8_BAR; PG8_SCHED;
            PG8_LDB(B1, 1, 1); PG8_STAGE(PG8_SB(1, 0), b3, voffB);
            PG8_BAR; PG8_WAIT_L(0); PG8_MMA(0, 1, At, B1); PG8_BAR;
            PG8_LDA(At, 1, 1); PG8_STAGE(PG8_SA(1, 0), a3, voffA);
            PG8_BAR; PG8_WAIT_L(0); PG8_MMA(1, 0, At, B0); PG8_BAR; PG8_SCHED;
            PG8_STAGE(PG8_SB(1, 1), b3 + hstepB, voffB);
            PG8_WAIT_V(6); PG8_BAR; PG8_MMA(1, 1, At, B1); PG8_BAR;
            }
        }
        if constexpr (ALIGN_EPI) { if (wr == 0) PG8_BAR; }
        if constexpr (!Epi::AFTER_DRAIN) { E(acc, cur, wr, wc, fr, fq); }
        if (!has_next) break;
#pragma unroll
        for (int a = 0; a < 2; ++a)
#pragma unroll
            for (int b = 0; b < 2; ++b)
#pragma unroll
                for (int m = 0; m < 4; ++m)
#pragma unroll
                    for (int n = 0; n < 2; ++n) acc[a][b][m][n] = (f32x4){0.f, 0.f, 0.f, 0.f};
        cur = nxt; cA = nA; cB = nB; ++ui;
        if constexpr (ALIGN_EPI) { if (wr == 1) PG8_BAR; }
    }
    PG8_WAIT_V(0);
    if constexpr (!ALIGN_EPI) { if (wr == 0) PG8_BAR; }
    PG8_BAR;
    if constexpr (Epi::AFTER_DRAIN) { E.fused(acc, cur, wr, wc, fr, fq, lds, wid, lane); }
#undef PG8_SA
#undef PG8_SB
#undef PG8_STAGE
#undef PG8_LDA
#undef PG8_LDB
#undef PG8_MMA
#undef PG8_WAIT_V
#undef PG8_WAIT_L
#undef PG8_BAR
#undef PG8_SCHED
}

DI void rstd_from_parts(const float* ss, int row0, int fq, float (&rs)[2][4]) {
#pragma unroll
    for (int ai = 0; ai < 2; ++ai)
#pragma unroll
        for (int m = 0; m < 4; ++m) {
            const f32x4* p = (const f32x4*)(ss + (size_t)(row0 + ai * HALF + m * 16) * 64 + fq * 16);
            const f32x4 a = p[0], b = p[1], c = p[2], d = p[3];
            float s = ((a[0] + a[1]) + (a[2] + a[3])) + ((b[0] + b[1]) + (b[2] + b[3])) + ((c[0] + c[1]) + (c[2] + c[3])) + ((d[0] + d[1]) + (d[2] + d[3]));
            s += __shfl_xor(s, 16); s += __shfl_xor(s, 32);
            rs[ai][m] = __builtin_amdgcn_rsqf(s * (1.0f / D) + EPS);
        }
}
struct EpiBf16 {
    static constexpr bool AFTER_DRAIN = false;
    bf16_t* base; const LAS float* rstd; const float* rstd_g;
    DI void operator()(const f32x4 (&acc)[2][2][4][2], const Unit& u, int wr, int wc, int fr, int fq) const {
        const int lrow = wr * 64 + fr, lcol = wc * 32 + 8 * fq;
#pragma unroll
        for (int ai = 0; ai < 2; ++ai)
#pragma unroll
            for (int m = 0; m < 4; ++m) { const int r = lrow + ai * HALF + m * 16; const float s = rstd ? rstd[r] : (rstd_g ? rstd_g[u.pm * BM + r] : 1.f);
                bf16_t* rowp = base + u.coff + (size_t)r * u.ldc + lcol;
#pragma unroll
                for (int bj = 0; bj < 2; ++bj) { const f32x4 v0 = acc[ai][bj][m][0] * s, v1 = acc[ai][bj][m][1] * s;
                    u32x4 w; w.x = cvt_pk_bf16(v0[0], v0[1]); w.y = cvt_pk_bf16(v0[2], v0[3]); w.z = cvt_pk_bf16(v1[0], v1[1]); w.w = cvt_pk_bf16(v1[2], v1[3]);
                    *(u32x4*)(rowp + bj * HALF) = w; } }
    }
};
template <bool RB16>
struct EpiResid {
    static constexpr bool AFTER_DRAIN = false;
    const void* resid; bf16_t* hb; float* sspart; float* out32;
    DI void operator()(const f32x4 (&acc)[2][2][4][2], const Unit& u, int wr, int wc, int fr, int fq) const {
        const int row0 = u.pm * BM + wr * 64 + fr, col0 = u.pn * BM + wc * 32 + 8 * fq;
#pragma unroll
        for (int ai = 0; ai < 2; ++ai) {
            u32x4 rb[4][2];
            if constexpr (RB16) {
#pragma unroll
                for (int m = 0; m < 4; ++m)
#pragma unroll
                    for (int bj = 0; bj < 2; ++bj) rb[m][bj] = *(const u32x4*)((const bf16_t*)resid + (size_t)(row0 + ai * HALF + m * 16) * D + col0 + bj * HALF);
            }
#pragma unroll
            for (int m = 0; m < 4; ++m) { const int row = row0 + ai * HALF + m * 16; const size_t off = (size_t)row * D + col0; float q = 0.f;
#pragma unroll
                for (int bj = 0; bj < 2; ++bj) { f32x4 r0, r1;
                    if constexpr (RB16) { const u32x4 w = rb[m][bj]; r0 = (f32x4){bflo(w.x), bfhi(w.x), bflo(w.y), bfhi(w.y)}; r1 = (f32x4){bflo(w.z), bfhi(w.z), bflo(w.w), bfhi(w.w)}; }
                    else { const float* rp = (const float*)resid + off + bj * HALF; r0 = *(const f32x4*)rp; r1 = *(const f32x4*)(rp + 4); }
                    const f32x4 h0 = r0 + acc[ai][bj][m][0], h1 = r1 + acc[ai][bj][m][1];
                    q += (h0[0] * h0[0] + h0[1] * h0[1]) + (h0[2] * h0[2] + h0[3] * h0[3]) + (h1[0] * h1[0] + h1[1] * h1[1]) + (h1[2] * h1[2] + h1[3] * h1[3]);
                    u32x4 w; w.x = cvt_pk_bf16(h0[0], h0[1]); w.y = cvt_pk_bf16(h0[2], h0[3]); w.z = cvt_pk_bf16(h1[0], h1[1]); w.w = cvt_pk_bf16(h1[2], h1[3]);
                    if (hb) *(u32x4*)(hb + off + bj * HALF) = w;
                    if (out32) { *(f32x4*)(out32 + off + bj * HALF) = h0; *(f32x4*)(out32 + off + bj * HALF + 4) = h1; } }
                q += __shfl_xor(q, 16); q += __shfl_xor(q, 32);
                if (fq == 0) sspart[(size_t)row * 64 + u.pn * 4 + wc] = q;
                if constexpr (!RB16) asm volatile("" ::: "memory"); }
        }
    }
};
struct EpiSwiglu {
    static constexpr bool AFTER_DRAIN = false;
    bf16_t* act; const LAS float* rstd_lds;
    DI void operator()(const f32x4 (&acc)[2][2][4][2], const Unit& u, int wr, int wc, int fr, int fq) const {
        const int row0 = u.pm * BM + wr * 64 + fr, col0 = u.pn * HALF + wc * 32 + 8 * fq;
        float rs[2][4];
#pragma unroll
        for (int ai = 0; ai < 2; ++ai)
#pragma unroll
            for (int m = 0; m < 4; ++m) rs[ai][m] = rstd_lds[wr * 64 + fr + ai * HALF + m * 16];
#pragma unroll
        for (int ai = 0; ai < 2; ++ai)
#pragma unroll
            for (int m = 0; m < 4; ++m) { const int row = row0 + ai * HALF + m * 16; const float r = rs[ai][m];
                float o[8];
#pragma unroll
                for (int n = 0; n < 2; ++n)
#pragma unroll
                    for (int e = 0; e < 4; ++e) { const float gt = acc[ai][0][m][n][e] * r, up = acc[ai][1][m][n][e] * r;
                        o[n * 4 + e] = gt * up * __builtin_amdgcn_rcpf(1.f + __expf(-gt)); }
                u32x4 w; w.x = cvt_pk_bf16(o[0], o[1]); w.y = cvt_pk_bf16(o[2], o[3]); w.z = cvt_pk_bf16(o[4], o[5]); w.w = cvt_pk_bf16(o[6], o[7]);
                *(u32x4*)(act + (size_t)row * FF + col0) = w; }
    }
};
struct EpiSoftmax {
    static constexpr bool AFTER_DRAIN = true;
    bf16_t* P; const float* sspart;
    DI void operator()(const f32x4 (&)[2][2][4][2], const Unit&, int, int, int, int) const {}
    DI void fused(f32x4 (&acc)[2][2][4][2], const Unit& u, int wr, int wc, int fr, int fq, LAS unsigned char* lds, int wid, int lane) const {
        const int lrow = wr * 64 + fr, row0 = u.pm * BM + lrow;
        float rs[2][4]; rstd_from_parts(sspart, row0, fq, rs);
        LAS f32x2* T = (LAS f32x2*)lds;
        float mw[2][4];
#pragma unroll
        for (int ai = 0; ai < 2; ++ai)
#pragma unroll
            for (int m = 0; m < 4; ++m) { const float sc = rs[ai][m] * (0.03125f * 1.4426950408889634f); float mx = -3.0e38f;
#pragma unroll
                for (int bj = 0; bj < 2; ++bj)
#pragma unroll
                    for (int n = 0; n < 2; ++n) { acc[ai][bj][m][n] = acc[ai][bj][m][n] * sc; const f32x4 x = acc[ai][bj][m][n]; mx = fmaxf(fmaxf(mx, fmaxf(x[0], x[1])), fmaxf(x[2], x[3])); }
                mx = fmaxf(mx, __shfl_xor(mx, 16)); mx = fmaxf(mx, __shfl_xor(mx, 32)); float l = 0.f;
#pragma unroll
                for (int bj = 0; bj < 2; ++bj)
#pragma unroll
                    for (int n = 0; n < 2; ++n) { f32x4 x = acc[ai][bj][m][n];
#pragma unroll
                        for (int e = 0; e < 4; ++e) { x[e] = __builtin_amdgcn_exp2f(x[e] - mx); l += x[e]; }
                        acc[ai][bj][m][n] = x; }
                l += __shfl_xor(l, 16); l += __shfl_xor(l, 32);
                mw[ai][m] = mx;
                if (fq == 0) T[(lrow + ai * HALF + m * 16) * 4 + wc] = (f32x2){mx, l}; }
        asm volatile("s_waitcnt lgkmcnt(0)" ::: "memory"); __builtin_amdgcn_s_barrier(); asm volatile("" ::: "memory");
        const int lcol = u.pn * BM + wc * 32 + 8 * fq;
#pragma unroll
        for (int ai = 0; ai < 2; ++ai)
#pragma unroll
            for (int m = 0; m < 4; ++m) { const int r = lrow + ai * HALF + m * 16;
                const f32x2 a = T[r * 4 + 0], b = T[r * 4 + 1], c = T[r * 4 + 2], d = T[r * 4 + 3];
                const float mx = fmaxf(fmaxf(a.x, b.x), fmaxf(c.x, d.x));
                const float L = a.y * __builtin_amdgcn_exp2f(a.x - mx) + b.y * __builtin_amdgcn_exp2f(b.x - mx) + c.y * __builtin_amdgcn_exp2f(c.x - mx) + d.y * __builtin_amdgcn_exp2f(d.x - mx);
                const float f = __builtin_amdgcn_exp2f(mw[ai][m] - mx) / L;
                bf16_t* rowp = P + (size_t)(u.pm * BM + r) * 1024 + lcol;
#pragma unroll
                for (int bj = 0; bj < 2; ++bj) { const f32x4 v0 = acc[ai][bj][m][0] * f, v1 = acc[ai][bj][m][1] * f;
                    u32x4 w; w.x = cvt_pk_bf16(v0[0], v0[1]); w.y = cvt_pk_bf16(v0[2], v0[3]); w.z = cvt_pk_bf16(v1[0], v1[1]); w.w = cvt_pk_bf16(v1[2], v1[3]);
                    *(u32x4*)(rowp + bj * HALF) = w; } }
    }
};
}

#define XB_TMO      128
#define XB_XCNT(j)  (256  + 64 * (j))
#define XB_XSUB(j)  (1280 + 64 * (j))
#define XB_XGEN(j)  (2304 + 64 * (j))
#define XB_TOP      3328
#define XB_TOPGEN   3392
#define XCD_BAR_WORDS 3456
#define XB_SPIN_CAP (1u << 18)
__device__ __forceinline__ unsigned xb_ld(unsigned* p)              { return __hip_atomic_load(p, __ATOMIC_RELAXED, __HIP_MEMORY_SCOPE_AGENT); }
__device__ __forceinline__ unsigned xb_add(unsigned* p, unsigned v) { return __hip_atomic_fetch_add(p, v, __ATOMIC_RELAXED, __HIP_MEMORY_SCOPE_AGENT); }
__device__ __forceinline__ unsigned xb_xcc_id() { return (unsigned)__builtin_amdgcn_s_getreg((3 << 11) | 20) & 0xFu; }
#define XB_SPIN(cond, bar) do { unsigned _sp = 0; while (cond) { __builtin_amdgcn_s_sleep(1); \
    if ((++_sp & 255u) == 0u) { if (xb_ld(&(bar)[XB_TMO])) break; if (_sp > XB_SPIN_CAP) { atomicAdd(&(bar)[XB_TMO], 1u); break; } } } } while (0)
struct XcdBarrier { unsigned* bar; unsigned x; volatile LAS unsigned* st; };
__device__ __forceinline__ XcdBarrier xcd_barrier_post(unsigned* bar, volatile LAS unsigned* st) {
    XcdBarrier b; b.bar = bar; b.x = xb_xcc_id(); b.st = st;
    if (threadIdx.x == 0) (void)xb_add(&bar[XB_XCNT(b.x)], 1u);
    return b;
}
__device__ __forceinline__ void xcd_barrier_complete(unsigned* bar, unsigned x, unsigned& nloc, unsigned& nx) {
    const unsigned G = gridDim.x * gridDim.y * gridDim.z;
    unsigned sum, cnt, mine, sp = 0u;
    for (;;) {
        sum = 0u; cnt = 0u; mine = 0u;
#pragma unroll
        for (unsigned j = 0; j < 16; ++j) { const unsigned c = xb_ld(&bar[XB_XCNT(j)]); sum += c; cnt += (c > 0u) ? 1u : 0u; mine = (j == x) ? c : mine; }
        if (sum == G) break;
        __builtin_amdgcn_s_sleep(1);
        if ((++sp & 255u) == 0u) { if (xb_ld(&bar[XB_TMO])) break; if (sp > XB_SPIN_CAP) { atomicAdd(&bar[XB_TMO], 1u); break; } }
    }
    nloc = mine > 0u ? mine : 1u; nx = cnt > 0u ? cnt : 1u;
}
__device__ __forceinline__ void xcd_barrier(const XcdBarrier& b) {
    asm volatile("s_waitcnt vmcnt(0)" ::: "memory");
    __syncthreads();
    if (threadIdx.x == 0) {
        unsigned* bar = b.bar;
        __builtin_amdgcn_s_waitcnt(0);
        unsigned nloc = b.st[0], nx = b.st[1];
        if (nloc == 0u) { xcd_barrier_complete(bar, b.x, nloc, nx); b.st[0] = nloc; b.st[1] = nx; }
        const unsigned old = xb_add(&bar[XB_XSUB(b.x)], 1u);
        const unsigned gen = old / nloc;
        if (old + 1u == (gen + 1u) * nloc) {
            __builtin_amdgcn_fence(__ATOMIC_RELEASE, "agent");
            asm volatile("s_waitcnt vmcnt(0)" ::: "memory");
            const unsigned og = xb_add(&bar[XB_TOP], 1u);
            const unsigned tg = og / nx;
            if (og + 1u == (tg + 1u) * nx) xb_add(&bar[XB_TOPGEN], 1u);
            else XB_SPIN(xb_ld(&bar[XB_TOPGEN]) == tg, bar);
            __builtin_amdgcn_fence(__ATOMIC_ACQUIRE, "agent");
            xb_add(&bar[XB_XGEN(b.x)], 1u);
            asm volatile("s_waitcnt vmcnt(0)" ::: "memory");
        } else {
            XB_SPIN(xb_ld(&bar[XB_XGEN(b.x)]) == gen, bar);
            __builtin_amdgcn_fence(__ATOMIC_ACQUIRE, "agent");
            asm volatile("s_waitcnt vmcnt(0)" ::: "memory");
        }
    }
    __syncthreads();
}

struct Args { const float* in[24]; float* out; unsigned char* ws; int ph_lo, ph_hi; };
enum { IN_X = 0, IN_MEM, IN_NMIXG, IN_WIN, IN_GW2, IN_GB, IN_GNORM, IN_CONVW, IN_CONVB, IN_IGB, IN_FGB, IN_MNORM, IN_WOUT, IN_NCROSSG, IN_NMEMG,
       IN_WQ, IN_WK, IN_WV, IN_WO, IN_NFFNG, IN_WGATE, IN_WUP, IN_WDOWN, IN_NFING };

struct Frame {
    LAS unsigned char* lds;
    unsigned char* ws;
    int tid, lane, wave, vcu, G, bx;
};

struct CvtItem { const float* W; const float* g; bf16_t* Wt; int ldw, k0, sc0, K, dr0, nat; };
DI void cvt_load(const CvtItem& it, int lane, f32x4 (&v)[16], f32x4 (&gq)[4]) {
    const int kq = lane >> 4, nl = lane & 15;
    const float* src = it.W + (size_t)(it.k0 + 16 * kq) * it.ldw + it.sc0 + 4 * nl;
#pragma unroll
    for (int i = 0; i < 16; ++i) v[i] = __builtin_nontemporal_load((const f32x4*)(src + (size_t)i * it.ldw));
    if (it.g) { const f32x4* gp = (const f32x4*)(it.g + it.k0 + 16 * kq);
#pragma unroll
        for (int q = 0; q < 4; ++q) gq[q] = gp[q]; }
    else {
#pragma unroll
        for (int q = 0; q < 4; ++q) gq[q] = (f32x4){1.f, 1.f, 1.f, 1.f}; }
}
DI void cvt_pack(const f32x4 (&v)[16], const f32x4 (&gq)[4], u32x4 (&pk)[8]) {
#pragma unroll
    for (int e = 0; e < 4; ++e) {
        pk[2 * e].x = cvt_pk_bf16(v[0][e] * gq[0][0], v[1][e] * gq[0][1]); pk[2 * e].y = cvt_pk_bf16(v[2][e] * gq[0][2], v[3][e] * gq[0][3]);
        pk[2 * e].z = cvt_pk_bf16(v[4][e] * gq[1][0], v[5][e] * gq[1][1]); pk[2 * e].w = cvt_pk_bf16(v[6][e] * gq[1][2], v[7][e] * gq[1][3]);
        pk[2 * e + 1].x = cvt_pk_bf16(v[8][e] * gq[2][0], v[9][e] * gq[2][1]); pk[2 * e + 1].y = cvt_pk_bf16(v[10][e] * gq[2][2], v[11][e] * gq[2][3]);
        pk[2 * e + 1].z = cvt_pk_bf16(v[12][e] * gq[3][0], v[13][e] * gq[3][1]); pk[2 * e + 1].w = cvt_pk_bf16(v[14][e] * gq[3][2], v[15][e] * gq[3][3]);
    }
}
DI void cvt_store(const CvtItem& it, int lane, const u32x4 (&pk)[8]) {
    const int kq = lane >> 4, nl = lane & 15;
    if (it.nat) {
#pragma unroll
        for (int hf = 0; hf < 2; ++hf)
#pragma unroll
            for (int j = 0; j < 4; ++j) { const unsigned w0 = pk[0 + hf][j], w1 = pk[2 + hf][j], w2 = pk[4 + hf][j], w3 = pk[6 + hf][j];
                u32x2 r0, r1; r0.x = (w0 & 0xffffu) | (w1 << 16); r0.y = (w2 & 0xffffu) | (w3 << 16); r1.x = (w0 >> 16) | (w1 & 0xffff0000u); r1.y = (w2 >> 16) | (w3 & 0xffff0000u);
                bf16_t* dst = it.Wt + (size_t)(it.k0 + 16 * kq + 8 * hf + 2 * j) * it.K + it.dr0 + 4 * nl;
                *(u32x2*)dst = r0; *(u32x2*)(dst + it.K) = r1; }
        return; }
#pragma unroll
    for (int e = 0; e < 4; ++e) { bf16_t* dst = it.Wt + (size_t)(it.dr0 + 4 * nl + e) * it.K + it.k0 + 16 * kq; *(u32x4*)dst = pk[2 * e]; *(u32x4*)(dst + 8) = pk[2 * e + 1]; }
}
template <int MAT> constexpr int cvt_count() { return MAT == 0 ? 64 * 192 : MAT == 5 ? 64 * 344 : MAT == 6 ? 172 * 64 : 64 * 64; }
template <int MAT>
DI CvtItem cvt_item(const Args& a, unsigned char* ws, int r) {
    if constexpr (MAT == 0) { const int kb = r / 192, nb = r % 192, n0 = 64 * nb; return CvtItem{a.in[IN_WIN], a.in[IN_NMIXG], (bf16_t*)(ws + WS_WIN), INCOLS, 64 * kb, n0 < 6144 ? n0 : n0 + 16, D, n0, 0}; }
    else if constexpr (MAT == 1) return CvtItem{a.in[IN_WOUT], nullptr, (bf16_t*)(ws + WS_WOUT), D, 64 * (r / 64), 64 * (r % 64), D, 64 * (r % 64), 0};
    else if constexpr (MAT == 2) return CvtItem{a.in[IN_WK], nullptr, (bf16_t*)(ws + WS_WK), D, 64 * (r / 64), 64 * (r % 64), D, 64 * (r % 64), 0};
    else if constexpr (MAT == 3) return CvtItem{a.in[IN_WV], nullptr, (bf16_t*)(ws + WS_WV), D, 64 * (r / 64), 64 * (r % 64), D, 64 * (r % 64), 0};
    else if constexpr (MAT == 4) return CvtItem{a.in[IN_WO], nullptr, (bf16_t*)(ws + WS_WO), D, 64 * (r / 64), 64 * (r % 64), D, 64 * (r % 64), 0};
    else if constexpr (MAT == 5) { const int kb = r / 344, nb = r % 344, n0 = 64 * nb, pn = n0 >> 8, j0 = n0 & 255; const float* W = a.in[IN_WGATE]; const float* W2 = a.in[IN_WUP];
        return CvtItem{W + ((j0 < 128) ? 0 : (W2 - W)), a.in[IN_NFFNG], (bf16_t*)(ws + WS_WGU), FF, 64 * kb, 128 * pn + (j0 & 127), D, n0, 0}; }
    else if constexpr (MAT == 6) return CvtItem{a.in[IN_WDOWN], nullptr, (bf16_t*)(ws + WS_WDN), D, 64 * (r / 64), 64 * (r % 64), FF, 64 * (r % 64), 0};
    else return CvtItem{a.in[IN_WQ], a.in[IN_NCROSSG], (bf16_t*)(ws + WS_WQ), D, 64 * (r / 64), 64 * (r % 64), D, 64 * (r % 64), 1};
}
DI void cvt_pack_store(const CvtItem& it, int lane, const f32x4 (&v)[16], const f32x4 (&gq)[4]) {
    const int kq = lane >> 4, nl = lane & 15;
    if (it.nat) { u32x4 pk[8]; cvt_pack(v, gq, pk); cvt_store(it, lane, pk); return; }
#pragma unroll
    for (int e = 0; e < 4; ++e) { u32x4 lo, hi;
        lo.x = cvt_pk_bf16(v[0][e] * gq[0][0], v[1][e] * gq[0][1]); lo.y = cvt_pk_bf16(v[2][e] * gq[0][2], v[3][e] * gq[0][3]);
        lo.z = cvt_pk_bf16(v[4][e] * gq[1][0], v[5][e] * gq[1][1]); lo.w = cvt_pk_bf16(v[6][e] * gq[1][2], v[7][e] * gq[1][3]);
        hi.x = cvt_pk_bf16(v[8][e] * gq[2][0], v[9][e] * gq[2][1]); hi.y = cvt_pk_bf16(v[10][e] * gq[2][2], v[11][e] * gq[2][3]);
        hi.z = cvt_pk_bf16(v[12][e] * gq[3][0], v[13][e] * gq[3][1]); hi.w = cvt_pk_bf16(v[14][e] * gq[3][2], v[15][e] * gq[3][3]);
        bf16_t* dst = it.Wt + (size_t)(it.dr0 + 4 * nl + e) * it.K + it.k0 + 16 * kq; *(u32x4*)dst = lo; *(u32x4*)(dst + 8) = hi; }
}
template <int MAT>
DI void cvt_range(const Args& a, unsigned char* ws, int it0, int it1, int gw, int nw, int lane) {
    f32x4 v0[16], v1[16], g0[4], g1[4];
    int ia = it0 + gw, ib = ia + nw; const int st = 2 * nw;
    CvtItem ca = cvt_item<MAT>(a, ws, ia < it1 ? ia : it0), cb = cvt_item<MAT>(a, ws, ib < it1 ? ib : it0);
    if (ia < it1) cvt_load(ca, lane, v0, g0);
    if (ib < it1) cvt_load(cb, lane, v1, g1);
    while (ia < it1) {
        { cvt_pack_store(ca, lane, v0, g0); ia += st; if (ia < it1) { ca = cvt_item<MAT>(a, ws, ia); cvt_load(ca, lane, v0, g0); } }
        if (ib < it1) { cvt_pack_store(cb, lane, v1, g1); ib += st; if (ib < it1) { cb = cvt_item<MAT>(a, ws, ib); cvt_load(cb, lane, v1, g1); } }
    }
}
DI void p0a_weights(const Frame& F, const Args& a) {
    const int gw = F.vcu * NWAVES + F.wave, NGW = F.G * NWAVES, lane = F.lane;
    unsigned char* ws = F.ws;
    cvt_range<0>(a, ws, 0, cvt_count<0>(), gw, NGW, lane);
    { const float* win = a.in[IN_WIN]; const float* g = a.in[IN_NMIXG]; bf16_t* o = (bf16_t*)(ws + WS_WSMALL);
      for (int i = F.vcu * 512 + F.tid; i < 32 * D; i += F.G * 512) { const int c = i >> 12, k = i & (D - 1);
          float v = 0.f; if (c < 24) { const int col = c < 16 ? 6144 + c : 12304 + (c - 16); v = win[(size_t)k * INCOLS + col] * g[k]; }
          o[((((k >> 5) * 2 + (c >> 4)) * 64 + ((k >> 3) & 3) * 16 + (c & 15)) << 3) + (k & 7)] = (bf16_t)f2bf(v); } }
    { const float* mem = a.in[IN_MEM]; const float* g = a.in[IN_NMEMG]; bf16_t* o = (bf16_t*)(ws + WS_MEMN);
      for (int row = gw; row < 512; row += NGW) { const f32x4* xr = (const f32x4*)(mem + (size_t)row * D) + lane; f32x4 v[16]; float s = 0.f;
#pragma unroll
          for (int j = 0; j < 16; ++j) { v[j] = xr[64 * j]; s += (v[j][0] * v[j][0] + v[j][1] * v[j][1]) + (v[j][2] * v[j][2] + v[j][3] * v[j][3]); }
          const float rstd = __builtin_amdgcn_rsqf(wave_sum(s) * (1.f / D) + EPS);
#pragma unroll
          for (int j = 0; j < 16; ++j) { const f32x4 gv = *((const f32x4*)g + lane + 64 * j); const f32x4 y = v[j] * rstd * gv;
              u32x2 w; w.x = pk2(y[0], y[1]); w.y = pk2(y[2], y[3]); *((u32x2*)(o + (size_t)row * D) + lane + 64 * j) = w; } } }
}
constexpr int CW_Q = 8192;
template <int MAT>
DI void cvt_queue(const Frame& F, const Args& a) {
    unsigned char* ws = F.ws; unsigned* ctr = (unsigned*)(ws + WS_CTL) + CW_Q + 64 * MAT; const int lane = F.lane; constexpr int N = cvt_count<MAT>();
    for (;;) {
        unsigned g = 0; if (lane == 0) g = __hip_atomic_fetch_add(ctr, 1u, __ATOMIC_RELAXED, __HIP_MEMORY_SCOPE_AGENT);
        g = (unsigned)__builtin_amdgcn_readfirstlane((int)g);
        const int it0 = (int)g * 8; if (it0 >= N) break;
        cvt_range<MAT>(a, ws, it0, it0 + 8 < N ? it0 + 8 : N, 0, 1, lane);
    }
}
DI void p0a_rest(const Frame& F, const Args& a) {
    cvt_queue<2>(F, a); cvt_queue<3>(F, a); cvt_queue<1>(F, a); cvt_queue<7>(F, a); cvt_queue<4>(F, a); cvt_queue<5>(F, a); cvt_queue<6>(F, a);
}

DI void p0b_x(const Frame& F, const Args& a) {
    const int gw = F.vcu * NWAVES + F.wave, NGW = F.G * NWAVES, lane = F.lane, r = lane & 15, q4 = lane >> 4;
    const float* x = a.in[IN_X]; unsigned char* ws = F.ws;
    bf16_t* xb = (bf16_t*)a.out; const bf16_t* wsm = (const bf16_t*)(ws + WS_WSMALL); float* rstd0 = (float*)(ws + WS_RSTD0); float* smallp = (float*)(ws + WS_SMALLP);
    LAS unsigned char* tile = F.lds + F.wave * 4352;
    LAS unsigned char* twr = tile + 8 * lane; const LAS unsigned char* trd = tile + (r & 7) * 528 + 16 * q4;
    for (int task = gw; task < M / 8; task += NGW) {
        const int R0 = task * 8;
        const float* xr = x + (size_t)R0 * D + 4 * lane; bf16_t* xo = xb + (size_t)R0 * D + 4 * lane;
        const bf16_t* w0 = wsm + 8 * lane;
        f32x4 acc0 = {0.f, 0.f, 0.f, 0.f}, acc1 = {0.f, 0.f, 0.f, 0.f}; float ss[8];
        f32x4 xv[8];
#pragma unroll
        for (int ro = 0; ro < 8; ++ro) { ss[ro] = 0.f; xv[ro] = __builtin_nontemporal_load((const f32x4*)(xr + (size_t)ro * D)); }
#define P0B_BLOCK(blk, NEXT) { bf16x8 b0[8], b1[8]; \
            _Pragma("unroll") for (int t = 0; t < 8; ++t) { b0[t] = *(const bf16x8*)(w0 + 1024 * (8 * (blk) + t)); b1[t] = *(const bf16x8*)(w0 + 1024 * (8 * (blk) + t) + 512); } \
            _Pragma("unroll") for (int ro = 0; ro < 8; ++ro) { const f32x4 p = xv[ro]; ss[ro] += (p[0] * p[0] + p[1] * p[1]) + (p[2] * p[2] + p[3] * p[3]); \
                u32x2 w; w.x = cvt_pk_bf16(p[0], p[1]); w.y = cvt_pk_bf16(p[2], p[3]); *(u32x2*)(xo + (size_t)ro * D + 256 * (blk)) = w; *(LAS u32x2*)(twr + ro * 528) = w; } \
            if (NEXT) { _Pragma("unroll") for (int ro = 0; ro < 8; ++ro) xv[ro] = __builtin_nontemporal_load((const f32x4*)(xr + (size_t)ro * D + 256 * ((blk) + 1))); } \
            bf16x8 af[8]; \
            _Pragma("unroll") for (int t = 0; t < 8; ++t) af[t] = *(const LAS bf16x8*)(trd + 64 * t); \
            _Pragma("unroll") for (int t = 0; t < 8; ++t) { acc0 = __builtin_amdgcn_mfma_f32_16x16x32_bf16(af[t], b0[t], acc0, 0, 0, 0); acc1 = __builtin_amdgcn_mfma_f32_16x16x32_bf16(af[t], b1[t], acc1, 0, 0, 0); } }
        for (int blk = 0; blk < 15; ++blk) P0B_BLOCK(blk, true)
        P0B_BLOCK(15, false)
#undef P0B_BLOCK
        float rs[8];
#pragma unroll
        for (int ro = 0; ro < 8; ++ro) rs[ro] = __builtin_amdgcn_rsqf(wave_sum(ss[ro]) * (1.f / D) + EPS);
        { float mine = rs[0];
#pragma unroll
          for (int ro = 1; ro < 8; ++ro) mine = (lane == ro) ? rs[ro] : mine;
          if (lane < 8) rstd0[R0 + lane] = mine; }
#pragma unroll
        for (int reg = 0; reg < 4; ++reg) { const int row = 4 * q4 + reg; const float rsr = q4 ? rs[4 + reg] : rs[reg];
            if (q4 < 2) { smallp[(size_t)(R0 + row) * 32 + r] = acc0[reg] * rsr; smallp[(size_t)(R0 + row) * 32 + 16 + r] = acc1[reg] * rsr; } }
    }
}

constexpr int QT_STRIDE = 528;
constexpr int PRE_QT = 0, PRE_KT = 64 * QT_STRIDE, PRE_PT = 2 * 64 * QT_STRIDE, PT_STRIDE = 272;
constexpr int PRE_MISC = PRE_PT + 64 * PT_STRIDE;
DI void pre_fetch(const Frame& F, int it, u32x4 (&qv4)[4], u32x4 (&kv4)[4]) {
    const int s = it >> 7, n = it & 127, b = (s >> 2) & 1, h = s & 3, tid = F.tid; const bool ml = s >= 8;
    const bf16_t* proj = (const bf16_t*)(F.ws + WS_PROJ) + (size_t)(b * SEQ + n * 64) * NPROJ + h * 256;
    const bf16_t* qsrc = proj + (ml ? C_QM : C_QG); const bf16_t* ksrc = proj + (ml ? C_KM : C_KG);
#pragma unroll
    for (int i = 0; i < 4; ++i) { const int p = tid + 512 * i, t = p >> 5, c8 = p & 31; qv4[i] = __builtin_nontemporal_load((const u32x4*)(qsrc + (size_t)t * NPROJ + 8 * c8)); kv4[i] = __builtin_nontemporal_load((const u32x4*)(ksrc + (size_t)t * NPROJ + 8 * c8)); }
}
template <bool ML>
DI void pre_item(const Frame& F, const Args& a, int s, int n, u32x4 (&qv4)[4], u32x4 (&kv4)[4], int nxt) {
    LAS unsigned char* lds = F.lds; unsigned char* ws = F.ws;
    const int tid = F.tid, lane = F.lane, wave = F.wave;
    const int b = (s >> 2) & 1, h = s & 3, sl = s & 7;
    const int T0 = b * SEQ + n * 64;
    const bf16_t* proj = (const bf16_t*)(ws + WS_PROJ); const float* smallp = (const float*)(ws + WS_SMALLP);
    LAS float* AG = (LAS float*)(lds + PRE_MISC); LAS float* HT = AG + 1024; LAS float* BB = HT + 256; LAS float* UU = BB + 64; LAS float* MLc = UU + 64; LAS float* WL = MLc + 64; LAS float* EE = WL + 64; LAS float* GG = EE + 64;
    const int d = tid & 255, th = tid >> 8;
    {
#pragma unroll
      for (int i = 0; i < 4; ++i) { const int p = tid + 512 * i, t = p >> 5, c8 = p & 31; *(LAS u32x4*)(lds + PRE_QT + t * QT_STRIDE + 16 * c8) = qv4[i]; *(LAS u32x4*)(lds + PRE_KT + t * QT_STRIDE + 16 * c8) = kv4[i]; } }
    if (!ML) {
        if (tid < 256) { const int t = tid >> 2, r4 = tid & 3; *(LAS f32x4*)(AG + t * 16 + 4 * r4) = *(const f32x4*)(smallp + (size_t)(T0 + t) * 32 + 4 * r4); }
        __syncthreads();
        float w2c[16]; const float* w2 = a.in[IN_GW2];
#pragma unroll
        for (int r = 0; r < 16; ++r) w2c[r] = w2[r * 1024 + h * 256 + d];
        const float gb = a.in[IN_GB][h * 256 + d];
        pre_fetch(F, nxt, qv4, kv4);
        float la[32]; float run = 0.f;
#pragma unroll
        for (int i = 0; i < 32; ++i) { const int t = 32 * th + i; float xg = gb;
#pragma unroll
            for (int q = 0; q < 4; ++q) { const f32x4 av = *(const LAS f32x4*)(AG + t * 16 + 4 * q); xg += av[0] * w2c[4 * q] + av[1] * w2c[4 * q + 1] + av[2] * w2c[4 * q + 2] + av[3] * w2c[4 * q + 3]; }
            la[i] = logsigmoidf(xg) * 0.0625f; run += la[i]; }
        if (th == 0) HT[d] = run;
        __syncthreads();
        float bc = th ? HT[d] : 0.f;
#pragma unroll
        for (int i = 0; i < 32; ++i) { const int t = 32 * th + i; bc += la[i];
            const float qv = bf2f(*(const LAS bf16_t*)(lds + PRE_QT + t * QT_STRIDE + 2 * d)), kv = bf2f(*(const LAS bf16_t*)(lds + PRE_KT + t * QT_STRIDE + 2 * d));
            const unsigned qk2 = cvt_pk_bf16(qv * 0.0625f * __expf(bc), kv * __expf(-bc));
            *(LAS bf16_t*)(lds + PRE_QT + t * QT_STRIDE + 2 * d) = (bf16_t)(qk2 & 0xffffu);
            *(LAS bf16_t*)(lds + PRE_KT + t * QT_STRIDE + 2 * d) = (bf16_t)(qk2 >> 16); }
        if (th == 1) ((float*)(ws + WS_DEC))[((size_t)sl * NCH + n) * 256 + d] = __expf(bc);
    } else {
        if (wave == 0) { const int t = lane;
            const float im = smallp[(size_t)(T0 + t) * 32 + 16 + h], fm = smallp[(size_t)(T0 + t) * 32 + 20 + h];
            const float ib = im + a.in[IN_IGB][h], lf = logsigmoidf(fm + a.in[IN_FGB][h]);
            float bb = lf;
#pragma unroll
            for (int o = 1; o < 64; o <<= 1) { const float y = __shfl_up(bb, o); if (lane >= o) bb += y; }
            const float u = ib - bb; float cm = u;
#pragma unroll
            for (int o = 1; o < 64; o <<= 1) { const float y = __shfl_up(cm, o); if (lane >= o) cm = fmaxf(cm, y); }
            const float blast = __shfl(bb, 63), cmax = __shfl(cm, 63);
            BB[t] = bb; UU[t] = u; MLc[t] = bb + cm; WL[t] = __expf(u - cmax); (void)blast;
            const float* egx = (const float*)(ws + WS_EGX) + (size_t)sl * 3 * SEQ + n * 64 + t;
            EE[t] = egx[0]; GG[t] = egx[SEQ];
        }
        __syncthreads();
        const float* cw = a.in[IN_CONVW]; const float* cb = a.in[IN_CONVB];
        const int chq = h * 256 + d, chk = 1024 + h * 256 + d;
        float wq[4], wk[4];
#pragma unroll
        for (int j = 0; j < 4; ++j) { wq[j] = cw[j * 2048 + chq]; wk[j] = cw[j * 2048 + chk]; }
        const float bq = cb[chq], bk = cb[chk];
        const int tfirst = 32 * th;
        float xq[3], xk[3];
        if (th) {
#pragma unroll
            for (int j = 0; j < 3; ++j) { xq[j] = bf2f(*(const LAS bf16_t*)(lds + PRE_QT + (29 + j) * QT_STRIDE + 2 * d)); xk[j] = bf2f(*(const LAS bf16_t*)(lds + PRE_KT + (29 + j) * QT_STRIDE + 2 * d)); }
        } else { const bf16_t* qp = proj + (size_t)T0 * NPROJ + C_QM + h * 256 + d; const bf16_t* kp = proj + (size_t)T0 * NPROJ + C_KM + h * 256 + d;
#pragma unroll
            for (int j = 0; j < 3; ++j) { const size_t back = (n > 0) ? (size_t)(3 - j) * NPROJ : 0; const float vq = bf2f(*(qp - back)), vk = bf2f(*(kp - back)); xq[j] = (n > 0) ? vq : 0.f; xk[j] = (n > 0) ? vk : 0.f; } }
        __syncthreads();
        pre_fetch(F, nxt, qv4, kv4);
        float ks = 0.f;
#pragma unroll
        for (int i = 0; i < 32; ++i) { const int t = tfirst + i;
            const float cq = bf2f(*(const LAS bf16_t*)(lds + PRE_QT + t * QT_STRIDE + 2 * d)), ck = bf2f(*(const LAS bf16_t*)(lds + PRE_KT + t * QT_STRIDE + 2 * d));
            const float yq = bq + wq[0] * xq[0] + wq[1] * xq[1] + wq[2] * xq[2] + wq[3] * cq;
            const float yk = bk + wk[0] * xk[0] + wk[1] * xk[1] + wk[2] * xk[2] + wk[3] * ck;
            xq[0] = xq[1]; xq[1] = xq[2]; xq[2] = cq; xk[0] = xk[1]; xk[1] = xk[2]; xk[2] = ck;
            const float qv = siluf_(yq), kv = siluf_(yk) * 0.0625f;
            const unsigned qk2 = cvt_pk_bf16(qv, kv);
            *(LAS bf16_t*)(lds + PRE_QT + t * QT_STRIDE + 2 * d) = (bf16_t)(qk2 & 0xffffu);
            *(LAS bf16_t*)(lds + PRE_KT + t * QT_STRIDE + 2 * d) = (bf16_t)(qk2 >> 16);
            ks += bfhi(qk2) * WL[t]; }
        if (th == 0) HT[d] = ks;
        __syncthreads();
        if (th == 1) ((float*)(ws + WS_KSUM))[((size_t)sl * NCH + n) * 256 + d] = ks + HT[d];
    }
    __syncthreads();
    bf16_t* Aq = (bf16_t*)(ws + (ML ? WS_AQM : WS_AQG)) + ((size_t)sl * NCH + n) * 16384;
    bf16_t* Ak = (bf16_t*)(ws + (ML ? WS_AKM : WS_AKG)) + ((size_t)sl * NCH + n) * 16384;
    bf16_t* Pm = (bf16_t*)(ws + (ML ? WS_PMM : WS_PMG)) + ((size_t)sl * NCH + n) * 4096;
#pragma unroll
    for (int i = 0; i < 4; ++i) { const int p = tid + 512 * i, w = p >> 8, tb = (p >> 7) & 1, ks = (p >> 6) & 1, l = p & 63, r = l & 31, hh = l >> 5;
        const int t = 32 * tb + r, d0 = 32 * w + 16 * ks + 4 * hh;
        const u32x2 lo = *(const LAS u32x2*)(lds + PRE_QT + t * QT_STRIDE + 2 * d0), hi = *(const LAS u32x2*)(lds + PRE_QT + t * QT_STRIDE + 2 * (d0 + 8));
        u32x4 o4 = (u32x4){lo.x, lo.y, hi.x, hi.y};
        if (ML) { const float gs = GG[t]; o4.x = cvt_pk_bf16(bflo(lo.x) * gs, bfhi(lo.x) * gs); o4.y = cvt_pk_bf16(bflo(lo.y) * gs, bfhi(lo.y) * gs); o4.z = cvt_pk_bf16(bflo(hi.x) * gs, bfhi(hi.x) * gs); o4.w = cvt_pk_bf16(bflo(hi.y) * gs, bfhi(hi.y) * gs); }
        *(u32x4*)(Aq + (size_t)p * 8) = o4; }
#pragma unroll
    for (int i = 0; i < 4; ++i) { const int p = tid + 512 * i, w = p >> 8, ks4 = (p >> 6) & 3, l = p & 63, r = l & 31, hh = l >> 5;
        const int dd = 32 * w + r, t0 = 16 * ks4 + 8 * hh; float kv[8];
#pragma unroll
        for (int j = 0; j < 8; ++j) { kv[j] = bf2f(*(const LAS bf16_t*)(lds + PRE_KT + (t0 + j) * QT_STRIDE + 2 * dd)); if (ML) kv[j] *= WL[t0 + j]; }
        u32x4 o; o.x = cvt_pk_bf16(kv[0], kv[1]); o.y = cvt_pk_bf16(kv[2], kv[3]); o.z = cvt_pk_bf16(kv[4], kv[5]); o.w = cvt_pk_bf16(kv[6], kv[7]);
        *(u32x4*)(Ak + (size_t)p * 8) = o; }
    { const int r16 = lane & 15, q4 = lane >> 4, tt = wave >> 1;
#pragma unroll
      for (int e2 = 0; e2 < 2; ++e2) { const int st = 2 * (wave & 1) + e2; f32x4 c = {0.f, 0.f, 0.f, 0.f};
          if (st <= tt) {
#pragma unroll
              for (int k = 0; k < 8; ++k) { const bf16x8 af = *(const LAS bf16x8*)(lds + PRE_QT + (16 * tt + r16) * QT_STRIDE + 2 * (32 * k + 8 * q4));
                  const bf16x8 bfr = *(const LAS bf16x8*)(lds + PRE_KT + (16 * st + r16) * QT_STRIDE + 2 * (32 * k + 8 * q4));
                  c = __builtin_amdgcn_mfma_f32_16x16x32_bf16(af, bfr, c, 0, 0, 0); } }
          const int scol = 16 * st + r16;
#pragma unroll
          for (int reg = 0; reg < 4; ++reg) { const int t = 16 * tt + 4 * q4 + reg; float v = (scol <= t) ? c[reg] : 0.f;
              if (ML) v = (scol <= t) ? v * (EE[t] * __expf(BB[t] - MLc[t] + UU[scol])) : 0.f;
              *(LAS float*)(lds + PRE_PT + t * PT_STRIDE + 4 * scol) = v; } } }
    __syncthreads();
    if (ML && tid < 64) { float rsum = 0.f;
#pragma unroll 8
        for (int j = 0; j < 64; ++j) rsum += *(const LAS float*)(lds + PRE_PT + tid * PT_STRIDE + 4 * j);
        ((float*)(ws + WS_RP))[(size_t)sl * SEQ + n * 64 + tid] = rsum; }
    { const int p = tid, tb = p >> 8, ks4 = (p >> 6) & 3, l = p & 63, r = l & 31, hh = l >> 5; const int t = 32 * tb + r, s0 = 16 * ks4 + 8 * hh;
      const f32x4 x0 = *(const LAS f32x4*)(lds + PRE_PT + t * PT_STRIDE + 4 * s0), x1 = *(const LAS f32x4*)(lds + PRE_PT + t * PT_STRIDE + 4 * (s0 + 4));
      u32x4 o; o.x = cvt_pk_bf16(x0[0], x0[1]); o.y = cvt_pk_bf16(x0[2], x0[3]); o.z = cvt_pk_bf16(x1[0], x1[1]); o.w = cvt_pk_bf16(x1[2], x1[3]);
      *(u32x4*)(Pm + (size_t)p * 8) = o; }
    __syncthreads();
}

DI void gate_scan(const Frame& F, const Args& a, int sl) {
    LAS float* sc = (LAS float*)F.lds;
    const int b = sl >> 2, h = sl & 3, lane = F.lane, w = F.wave;
    const float* smallp = (const float*)(F.ws + WS_SMALLP);
    const float bi = a.in[IN_IGB][h], bfg = a.in[IN_FGB][h];
    float bbv[16], mlv[16];
#pragma unroll
    for (int i = 0; i < 16; ++i) { const int n = w + 8 * i; const size_t row = (size_t)b * SEQ + n * 64 + lane;
        const float ib = smallp[row * 32 + 16 + h] + bi, lf = logsigmoidf(smallp[row * 32 + 20 + h] + bfg);
        float bb = lf;
#pragma unroll
        for (int o = 1; o < 64; o <<= 1) { const float y = __shfl_up(bb, o); if (lane >= o) bb += y; }
        const float u = ib - bb; float cm = u;
#pragma unroll
        for (int o = 1; o < 64; o <<= 1) { const float y = __shfl_up(cm, o); if (lane >= o) cm = fmaxf(cm, y); }
        const float blast = __shfl(bb, 63), cmax = __shfl(cm, 63);
        bbv[i] = bb; mlv[i] = bb + cm; if (lane == 0) { sc[2 * n] = blast; sc[2 * n + 1] = blast + cmax; } }
    __syncthreads();
    if (F.tid == 0) { float m = 0.f; float* db = (float*)(F.ws + WS_DB) + (size_t)sl * NCH * 2;
        for (int n = 0; n < NCH; ++n) { sc[256 + n] = m; const float bl = sc[2 * n], cn = sc[2 * n + 1], mn = fmaxf(bl + m, cn);
            db[2 * n] = __expf(bl + m - mn); db[2 * n + 1] = __expf(cn - mn); m = mn; } }
    __syncthreads();
    float* egx = (float*)(F.ws + WS_EGX) + (size_t)sl * 3 * SEQ;
#pragma unroll
    for (int i = 0; i < 16; ++i) { const int n = w + 8 * i; const float mp = sc[256 + n], il = bbv[i] + mp, mt = fmaxf(il, mlv[i]);
        egx[n * 64 + lane] = __expf(mlv[i] - mt); egx[SEQ + n * 64 + lane] = __expf(il - mt); egx[2 * SEQ + n * 64 + lane] = __expf(-mt); }
    __syncthreads();
}

DI bf16x8 pack8(float a0, float a1, float a2, float a3, float a4, float a5, float a6, float a7) {
    u32x4 p; p.x = cvt_pk_bf16(a0, a1); p.y = cvt_pk_bf16(a2, a3); p.z = cvt_pk_bf16(a4, a5); p.w = cvt_pk_bf16(a6, a7);
    return __builtin_bit_cast(bf16x8, p);
}
#define MFMA32(a, b, c) __builtin_amdgcn_mfma_f32_32x32x16_bf16((a), (b), (c), 0, 0, 0)
struct ScanOps { u32x4 aq[4], ak[4], pm; f32x4 dec[4]; float sc, ks; };
struct ScanCtx {
    LAS unsigned char* lds; const unsigned char *aqB, *akB, *pmB, *decB, *vB, *pfA, *pfV; const float *dbB, *ksB; float* npB; bf16_t* outp;
    size_t pfAstep; unsigned lo16, vaddr; int tid, lane, w, c, hh, slice;
};
template <bool ML>
DI void scan_load(const ScanCtx& X, ScanOps& o, int n) {
#pragma unroll
    for (int f = 0; f < 4; ++f) { o.aq[f] = *(const u32x4*)(X.aqB + (size_t)n * 32768 + f * 1024 + X.lo16); o.ak[f] = *(const u32x4*)(X.akB + (size_t)n * 32768 + f * 1024 + X.lo16); }
    o.pm = *(const u32x4*)(X.pmB + (size_t)n * 8192 + X.lo16);
    if (!ML) {
#pragma unroll
        for (int g = 0; g < 4; ++g) o.dec[g] = *(const f32x4*)(X.decB + (size_t)n * 1024 + 32 * g + 16 * X.hh);
    } else { o.sc = X.dbB[n * 2 + (X.lane & 1)]; if (X.slice == 0) o.ks = X.ksB[(size_t)n * 256]; }
}
template <bool ML, int PAR>
DI void scan_step(const ScanCtx& X, const ScanOps& cur, ScanOps& nxt, f32x16& S, float& nreg, int n, u32x4& vnew, const u32x4& vold) {
    LAS unsigned char* lds = X.lds; const int w = X.w, c = X.c, hh = X.hh;
    constexpr int PF = 4;
    u32x4 pf0 = {0u, 0u, 0u, 0u}, pf1 = {0u, 0u, 0u, 0u};
    if (n + PF < NCH) { if (X.tid < 288) pf0 = *(const u32x4*)(X.pfA + (size_t)(n + PF) * X.pfAstep); if (X.tid < 256) pf1 = *(const u32x4*)(X.pfV + (size_t)(n + PF) * (64 * NPROJ * 2)); }
    const bool more = (n + 1 < NCH);
    if (n + 2 < NCH && X.tid < 256) vnew = *(const u32x4*)(X.vB + (size_t)(n + 2) * (64 * NPROJ * 2));
    scan_load<ML>(X, nxt, more ? n + 1 : n);
    u32x2 tv[8];
    { const unsigned va = X.vaddr + (unsigned)(n & 3) * 4096u;
      asm volatile("ds_read_b64_tr_b16 %0, %8\n\tds_read_b64_tr_b16 %1, %8 offset:256\n\tds_read_b64_tr_b16 %2, %8 offset:1024\n\tds_read_b64_tr_b16 %3, %8 offset:1280\n\t"
                   "ds_read_b64_tr_b16 %4, %8 offset:2048\n\tds_read_b64_tr_b16 %5, %8 offset:2304\n\tds_read_b64_tr_b16 %6, %8 offset:3072\n\tds_read_b64_tr_b16 %7, %8 offset:3328\n\t"
                   "s_waitcnt lgkmcnt(0)"
                   : "=&v"(tv[0]), "=&v"(tv[1]), "=&v"(tv[2]), "=&v"(tv[3]), "=&v"(tv[4]), "=&v"(tv[5]), "=&v"(tv[6]), "=&v"(tv[7]) : "v"(va) : "memory"); }
    bf16x8 Bv[4];
#pragma unroll
    for (int k = 0; k < 4; ++k) Bv[k] = __builtin_bit_cast(bf16x8, (u32x4){tv[2 * k].x, tv[2 * k].y, tv[2 * k + 1].x, tv[2 * k + 1].y});
    const bf16x8 Bs0 = pack8(S[0], S[1], S[2], S[3], S[4], S[5], S[6], S[7]);
    const bf16x8 Bs1 = pack8(S[8], S[9], S[10], S[11], S[12], S[13], S[14], S[15]);
    f32x16 zero;
#pragma unroll
    for (int i = 0; i < 16; ++i) zero[i] = 0.f;
    f32x16 o0 = MFMA32(__builtin_bit_cast(bf16x8, cur.aq[0]), Bs0, zero); o0 = MFMA32(__builtin_bit_cast(bf16x8, cur.aq[1]), Bs1, o0);
    f32x16 o1 = MFMA32(__builtin_bit_cast(bf16x8, cur.aq[2]), Bs0, zero); o1 = MFMA32(__builtin_bit_cast(bf16x8, cur.aq[3]), Bs1, o1);
    { const bf16x8 pa = __builtin_bit_cast(bf16x8, cur.pm); bf16x8 bsel;
      if ((w >> 1) == 0) bsel = Bv[0]; else if ((w >> 1) == 1) bsel = Bv[1]; else if ((w >> 1) == 2) bsel = Bv[2]; else bsel = Bv[3];
      if ((w & 1) == 0) o0 = MFMA32(pa, bsel, o0); else o1 = MFMA32(pa, bsel, o1); }
    f32x16 U = MFMA32(__builtin_bit_cast(bf16x8, cur.ak[0]), Bv[0], zero);
    U = MFMA32(__builtin_bit_cast(bf16x8, cur.ak[1]), Bv[1], U); U = MFMA32(__builtin_bit_cast(bf16x8, cur.ak[2]), Bv[2], U); U = MFMA32(__builtin_bit_cast(bf16x8, cur.ak[3]), Bv[3], U);
    { LAS unsigned char* img = lds + PAR * 65536 + w * 8192 + c * 256;
#pragma unroll
      for (int g = 0; g < 4; ++g) { const int tq0 = 2 * g + hh, tq1 = 8 + 2 * g + hh;
          *(LAS f32x4*)(img + ((tq0 + c) & 15) * 16) = (f32x4){o0[4 * g], o0[4 * g + 1], o0[4 * g + 2], o0[4 * g + 3]};
          *(LAS f32x4*)(img + ((tq1 + c) & 15) * 16) = (f32x4){o1[4 * g], o1[4 * g + 1], o1[4 * g + 2], o1[4 * g + 3]}; } }
    if (!ML) {
#pragma unroll
        for (int i = 0; i < 16; ++i) S[i] = cur.dec[i >> 2][i & 3] * (S[i] + U[i]);
    } else {
        const float decay = __builtin_bit_cast(float, __builtin_amdgcn_readlane(__builtin_bit_cast(int, cur.sc), 0)), beta = __builtin_bit_cast(float, __builtin_amdgcn_readlane(__builtin_bit_cast(int, cur.sc), 1));
#pragma unroll
        for (int i = 0; i < 16; ++i) S[i] = decay * S[i] + beta * U[i];
        if (X.slice == 0 && hh == 0) { X.npB[(size_t)n * 256] = nreg; nreg = decay * nreg + beta * cur.ks; }
    }
    if (more && X.tid < 256) *(LAS u32x4*)(lds + LDS_X0 + ((n + 1) & 3) * 4096 + X.tid * 16) = vold;
    asm volatile("s_waitcnt lgkmcnt(0)" ::: "memory"); __builtin_amdgcn_s_barrier(); asm volatile("" ::: "memory");
    { const int tq = 2 * w + hh; f32x4 acc = {0.f, 0.f, 0.f, 0.f};
      const LAS unsigned char* img = lds + PAR * 65536 + c * 256 + ((tq + c) & 15) * 16;
#pragma unroll
      for (int w2 = 0; w2 < 8; ++w2) acc = acc + *(const LAS f32x4*)(img + w2 * 8192);
      bf16_t* op = X.outp + ((size_t)n * 64 + 4 * tq) * 2048;
      const unsigned p01 = cvt_pk_bf16(acc[0], acc[1]), p23 = cvt_pk_bf16(acc[2], acc[3]);
      op[0] = (bf16_t)(p01 & 0xffffu); op[2048] = (bf16_t)(p01 >> 16); op[2 * 2048] = (bf16_t)(p23 & 0xffffu); op[3 * 2048] = (bf16_t)(p23 >> 16); }
    asm volatile("" :: "v"(pf0.x), "v"(pf1.x));
}
template <bool ML>
DI void scan_stream(const Frame& F, const Args& a, int s, int slice) {
    unsigned char* ws = F.ws;
    const int b = (s >> 2) & 1, h = s & 3, sl = s & 7;
    const size_t T0 = (size_t)b * SEQ;
    ScanCtx X;
    X.lds = F.lds; X.tid = F.tid; X.lane = F.lane; X.w = F.wave; X.c = F.lane & 31; X.hh = F.lane >> 5; X.slice = slice; X.lo16 = (unsigned)F.lane * 16u;
    const unsigned char* proj = ws + WS_PROJ;
    const int vcol = (ML ? C_VM : C_VG) + h * 512 + 32 * slice;
    X.outp = (bf16_t*)(ws + (ML ? WS_OUTM : WS_OUTG)) + T0 * 2048 + h * 512 + 32 * slice + X.c;
    X.aqB = ws + (ML ? WS_AQM : WS_AQG) + (size_t)sl * NCH * 32768 + X.w * 4096;
    X.akB = ws + (ML ? WS_AKM : WS_AKG) + (size_t)sl * NCH * 32768 + X.w * 4096;
    X.pmB = ws + (ML ? WS_PMM : WS_PMG) + (size_t)sl * NCH * 8192 + ((X.w & 1) * 4 + (X.w >> 1)) * 1024;
    X.decB = ws + WS_DEC + ((size_t)sl * NCH * 256 + 32 * X.w) * 4;
    X.dbB = (const float*)(ws + WS_DB) + (size_t)sl * NCH * 2;
    X.ksB = (const float*)(ws + WS_KSUM) + (size_t)sl * NCH * 256 + 32 * X.w + X.c;
    X.npB = (float*)(ws + WS_NPREV) + (size_t)sl * NCH * 256 + 32 * X.w + X.c;
    X.vB = proj + ((T0 + (F.tid >> 2)) * NPROJ + vcol + 8 * (F.tid & 3)) * 2;
    X.vaddr = (unsigned)(size_t)(F.lds + LDS_X0) + (8 * X.hh + ((F.lane & 15) >> 2)) * 64 + 32 * ((F.lane >> 4) & 1) + 8 * (F.lane & 3);
    { const int pq = slice * 288 + F.tid;
      X.pfA = (pq < 2048) ? ws + (ML ? WS_AQM : WS_AQG) + ((size_t)sl * NCH * 2048 + pq) * 16
            : (pq < 4096) ? ws + (ML ? WS_AKM : WS_AKG) + ((size_t)sl * NCH * 2048 + (pq - 2048)) * 16
                          : ws + (ML ? WS_PMM : WS_PMG) + ((size_t)sl * NCH * 512 + (pq - 4096)) * 16;
      X.pfAstep = (pq < 4096) ? 32768 : 8192;
      X.pfV = proj + ((T0 + 4 * slice + (F.tid >> 6)) * NPROJ + (ML ? C_VM : C_VG) + h * 512 + 8 * (F.tid & 63)) * 2; }
    f32x16 S;
#pragma unroll
    for (int i = 0; i < 16; ++i) S[i] = 0.f;
    float nreg = 0.f;
    ScanOps A, B;
    A.sc = 0.f; A.ks = 0.f; B.sc = 0.f; B.ks = 0.f;
    scan_load<ML>(X, A, 0);
    u32x4 vA = {0u, 0u, 0u, 0u}, vB = {0u, 0u, 0u, 0u};
    if (F.tid < 256) { const u32x4 v0 = *(const u32x4*)X.vB; vB = *(const u32x4*)(X.vB + (size_t)(64 * NPROJ * 2)); *(LAS u32x4*)(F.lds + LDS_X0 + F.tid * 16) = v0; }
    __syncthreads();
    for (int n = 0; n < NCH; n += 2) {
        scan_step<ML, 0>(X, A, B, S, nreg, n, vA, vB);
        scan_step<ML, 1>(X, B, A, S, nreg, n + 1, vB, vA);
    }
    __syncthreads();
}

struct Scan2Ops { u32x4 aq[4], ak[4]; };
template <bool ML>
DI void scan2_load(const ScanCtx& X, Scan2Ops& o, int n) {
#pragma unroll
    for (int f = 0; f < 4; ++f) { o.aq[f] = *(const u32x4*)(X.aqB + (size_t)n * 32768 + f * 1024 + X.lo16); o.ak[f] = *(const u32x4*)(X.akB + (size_t)n * 32768 + f * 1024 + X.lo16); }
}
template <bool ML, int PAR>
DI void scan2_step(const ScanCtx& X, const Scan2Ops& cur, Scan2Ops& nxt, f32x16& S0, f32x16& S1, float& nreg, int n) {
    LAS unsigned char* lds = X.lds; const int w = X.w, c = X.c, hh = X.hh;
    const bool more = (n + 1 < NCH);
    u32x4 vnext = {0u, 0u, 0u, 0u};
    const u32x4 cpm = *(const u32x4*)(X.pmB + (size_t)n * 8192 + X.lo16);
    scan2_load<ML>(X, nxt, more ? n + 1 : n);
    f32x4 dec[4]; float csc = 0.f, cks = 0.f;
    if (!ML) {
#pragma unroll
        for (int g = 0; g < 4; ++g) dec[g] = *(const f32x4*)(X.decB + (size_t)n * 1024 + 32 * g + 16 * X.hh);
    } else { csc = X.dbB[n * 2 + (X.lane & 1)]; if (X.slice == 0) cks = X.ksB[(size_t)n * 256]; }
    f32x16 zero;
#pragma unroll
    for (int i = 0; i < 16; ++i) zero[i] = 0.f;
    float decay = 1.f, beta = 1.f;
    if (ML) { decay = __builtin_bit_cast(float, __builtin_amdgcn_readlane(__builtin_bit_cast(int, csc), 0)); beta = __builtin_bit_cast(float, __builtin_amdgcn_readlane(__builtin_bit_cast(int, csc), 1)); }
    LAS unsigned char* img = lds + PAR * 65536 + w * 8192;
#pragma unroll
    for (int ct = 0; ct < 2; ++ct) {
        u32x2 tv[8];
        { const unsigned va = X.vaddr + (unsigned)(n & 1) * 8192u + (unsigned)ct * 64u;
          asm volatile("ds_read_b64_tr_b16 %0, %8\n\tds_read_b64_tr_b16 %1, %8 offset:512\n\tds_read_b64_tr_b16 %2, %8 offset:2048\n\tds_read_b64_tr_b16 %3, %8 offset:2560\n\t"
                       "ds_read_b64_tr_b16 %4, %8 offset:4096\n\tds_read_b64_tr_b16 %5, %8 offset:4608\n\tds_read_b64_tr_b16 %6, %8 offset:6144\n\tds_read_b64_tr_b16 %7, %8 offset:6656\n\t"
                       "s_waitcnt lgkmcnt(0)"
                       : "=&v"(tv[0]), "=&v"(tv[1]), "=&v"(tv[2]), "=&v"(tv[3]), "=&v"(tv[4]), "=&v"(tv[5]), "=&v"(tv[6]), "=&v"(tv[7]) : "v"(va) : "memory"); }
        bf16x8 Bv[4];
#pragma unroll
        for (int k = 0; k < 4; ++k) Bv[k] = __builtin_bit_cast(bf16x8, (u32x4){tv[2 * k].x, tv[2 * k].y, tv[2 * k + 1].x, tv[2 * k + 1].y});
        const bf16x8 Ba = ct ? pack8(S1[0], S1[1], S1[2], S1[3], S1[4], S1[5], S1[6], S1[7]) : pack8(S0[0], S0[1], S0[2], S0[3], S0[4], S0[5], S0[6], S0[7]);
        const bf16x8 Bb = ct ? pack8(S1[8], S1[9], S1[10], S1[11], S1[12], S1[13], S1[14], S1[15]) : pack8(S0[8], S0[9], S0[10], S0[11], S0[12], S0[13], S0[14], S0[15]);
        { const bf16x8 pa = __builtin_bit_cast(bf16x8, cpm); bf16x8 bsel;
          if ((w >> 1) == 0) bsel = Bv[0]; else if ((w >> 1) == 1) bsel = Bv[1]; else if ((w >> 1) == 2) bsel = Bv[2]; else bsel = Bv[3];
          LAS unsigned char* ic = img + (32 * ct + c) * 128;
          { f32x16 o = MFMA32(__builtin_bit_cast(bf16x8, cur.aq[0]), Ba, zero); o = MFMA32(__builtin_bit_cast(bf16x8, cur.aq[1]), Bb, o);
            if ((w & 1) == 0) o = MFMA32(pa, bsel, o);
#pragma unroll
            for (int g = 0; g < 4; ++g) *(LAS u32x2*)(ic + ((2 * g + hh + c) & 15) * 8) = (u32x2){cvt_pk_bf16(o[4 * g], o[4 * g + 1]), cvt_pk_bf16(o[4 * g + 2], o[4 * g + 3])}; }
          { f32x16 o = MFMA32(__builtin_bit_cast(bf16x8, cur.aq[2]), Ba, zero); o = MFMA32(__builtin_bit_cast(bf16x8, cur.aq[3]), Bb, o);
            if ((w & 1) == 1) o = MFMA32(pa, bsel, o);
#pragma unroll
            for (int g = 0; g < 4; ++g) *(LAS u32x2*)(ic + ((8 + 2 * g + hh + c) & 15) * 8) = (u32x2){cvt_pk_bf16(o[4 * g], o[4 * g + 1]), cvt_pk_bf16(o[4 * g + 2], o[4 * g + 3])}; } }
        f32x16 U = MFMA32(__builtin_bit_cast(bf16x8, cur.ak[0]), Bv[0], zero);
        U = MFMA32(__builtin_bit_cast(bf16x8, cur.ak[1]), Bv[1], U); U = MFMA32(__builtin_bit_cast(bf16x8, cur.ak[2]), Bv[2], U); U = MFMA32(__builtin_bit_cast(bf16x8, cur.ak[3]), Bv[3], U);
        if (ct == 0) {
            if (more) vnext = *(const u32x4*)(X.vB + (size_t)(n + 1) * (64 * NPROJ * 2));
#pragma unroll
            for (int i = 0; i < 16; ++i) S0[i] = ML ? decay * S0[i] + beta * U[i] : dec[i >> 2][i & 3] * (S0[i] + U[i]);
        } else {
#pragma unroll
            for (int i = 0; i < 16; ++i) S1[i] = ML ? decay * S1[i] + beta * U[i] : dec[i >> 2][i & 3] * (S1[i] + U[i]);
        }
    }
    if (ML && X.slice == 0 && hh == 0) { X.npB[(size_t)n * 256] = nreg; nreg = decay * nreg + beta * cks; }
    if (more) *(LAS u32x4*)(lds + LDS_X0 + ((n + 1) & 1) * 8192 + (X.tid >> 3) * 128 + (X.tid & 7) * 16) = vnext;
    asm volatile("s_waitcnt lgkmcnt(0)" ::: "memory"); __builtin_amdgcn_s_barrier(); asm volatile("" ::: "memory");
    { const int q8 = 2 * w + hh;
#pragma unroll
      for (int ct = 0; ct < 2; ++ct) { f32x4 acc = {0.f, 0.f, 0.f, 0.f};
          const LAS unsigned char* ir = lds + PAR * 65536 + (32 * ct + c) * 128 + ((q8 + c) & 15) * 8;
#pragma unroll
          for (int w2 = 0; w2 < 8; ++w2) { const u32x2 v2 = *(const LAS u32x2*)(ir + w2 * 8192); acc = acc + (f32x4){bflo(v2.x), bfhi(v2.x), bflo(v2.y), bfhi(v2.y)}; }
          bf16_t* op = X.outp + ((size_t)n * 64 + 4 * q8) * 2048 + 32 * ct;
          const unsigned p01 = cvt_pk_bf16(acc[0], acc[1]), p23 = cvt_pk_bf16(acc[2], acc[3]);
          op[0] = (bf16_t)(p01 & 0xffffu); op[2048] = (bf16_t)(p01 >> 16); op[2 * 2048] = (bf16_t)(p23 & 0xffffu); op[3 * 2048] = (bf16_t)(p23 >> 16); } }
}
template <bool ML>
DI void scan2_stream(const Frame& F, const Args& a, int s, int slice2) {
    unsigned char* ws = F.ws;
    const int b = (s >> 2) & 1, h = s & 3, sl = s & 7;
    const size_t T0 = (size_t)b * SEQ;
    ScanCtx X;
    X.lds = F.lds; X.tid = F.tid; X.lane = F.lane; X.w = F.wave; X.c = F.lane & 31; X.hh = F.lane >> 5; X.slice = slice2; X.lo16 = (unsigned)F.lane * 16u;
    const unsigned char* proj = ws + WS_PROJ;
    const int vcol = (ML ? C_VM : C_VG) + h * 512 + 64 * slice2;
    X.outp = (bf16_t*)(ws + (ML ? WS_OUTM : WS_OUTG)) + T0 * 2048 + h * 512 + 64 * slice2 + X.c;
    X.aqB = ws + (ML ? WS_AQM : WS_AQG) + (size_t)sl * NCH * 32768 + X.w * 4096;
    X.akB = ws + (ML ? WS_AKM : WS_AKG) + (size_t)sl * NCH * 32768 + X.w * 4096;
    X.pmB = ws + (ML ? WS_PMM : WS_PMG) + (size_t)sl * NCH * 8192 + ((X.w & 1) * 4 + (X.w >> 1)) * 1024;
    X.decB = ws + WS_DEC + ((size_t)sl * NCH * 256 + 32 * X.w) * 4;
    X.dbB = (const float*)(ws + WS_DB) + (size_t)sl * NCH * 2;
    X.ksB = (const float*)(ws + WS_KSUM) + (size_t)sl * NCH * 256 + 32 * X.w + X.c;
    X.npB = (float*)(ws + WS_NPREV) + (size_t)sl * NCH * 256 + 32 * X.w + X.c;
    X.vB = proj + ((T0 + (F.tid >> 3)) * NPROJ + vcol + 8 * (F.tid & 7)) * 2;
    X.vaddr = (unsigned)(size_t)(F.lds + LDS_X0) + (8 * X.hh + ((F.lane & 15) >> 2)) * 128 + 32 * ((F.lane >> 4) & 1) + 8 * (F.lane & 3);
    X.pfA = nullptr; X.pfV = nullptr; X.pfAstep = 0;
    f32x16 S0, S1;
#pragma unroll
    for (int i = 0; i < 16; ++i) { S0[i] = 0.f; S1[i] = 0.f; }
    float nreg = 0.f;
    Scan2Ops A, B;
    scan2_load<ML>(X, A, 0);
    { const u32x4 v0 = *(const u32x4*)X.vB; *(LAS u32x4*)(F.lds + LDS_X0 + (F.tid >> 3) * 128 + (F.tid & 7) * 16) = v0; }
    __syncthreads();
    for (int n = 0; n < NCH; n += 2) {
        scan2_step<ML, 0>(X, A, B, S0, S1, nreg, n);
        scan2_step<ML, 1>(X, B, A, S0, S1, nreg, n + 1);
    }
    __syncthreads();
}

DI void post_fetch(const Frame& F, int t, int i, u32x4 (&ov)[4], u32x4 (&gv)[4]) {
    const int row = t >> 1, ml = (t ^ i) & 1, lane = F.lane;
    const bf16_t* op = (const bf16_t*)(F.ws + (ml ? WS_OUTM : WS_OUTG)) + (size_t)row * 2048 + 8 * lane;
    const bf16_t* gp = (const bf16_t*)(F.ws + WS_PROJ) + (size_t)row * NPROJ + (ml ? C_OM : C_GG) + 8 * lane;
#pragma unroll
    for (int h = 0; h < 4; ++h) { ov[h] = __builtin_nontemporal_load((const u32x4*)(op + h * 512)); gv[h] = __builtin_nontemporal_load((const u32x4*)(gp + h * 512)); }
}
DI void post_pass(const Frame& F, const Args& a, int wi, int nwg, int t0, int t1) {
    unsigned char* ws = F.ws; const int lane = F.lane;
    const int gw = wi * NWAVES + F.wave, NGW = nwg * NWAVES;
    bf16_t* mixed = (bf16_t*)(ws + WS_MIXED);
    u32x4 ov[4], gv[4];
    if (t0 + gw < t1) post_fetch(F, t0 + gw, 0, ov, gv);
    for (int task = t0 + gw, it = 0; task < t1; task += NGW, ++it) {
        const int row = task >> 1, ml = (task ^ it) & 1;
        const float* ng = a.in[ml ? IN_MNORM : IN_GNORM] + 8 * lane;
        f32x4 n0[4], n1[4];
#pragma unroll
        for (int h = 0; h < 4; ++h) { n0[h] = *(const f32x4*)(ng + h * 512); n1[h] = *(const f32x4*)(ng + h * 512 + 4); }
        float inv[4] = {1.f, 1.f, 1.f, 1.f};
        float Xx[4], rr[4]; u32x4 qv[4]; f32x4 na[4], nb[4];
        if (ml) {
            const int b = row >> 13, tl = row & (SEQ - 1), n = tl >> 6, tt = tl & 63, tb = tt >> 5, r = tt & 31;
            const int w = (lane & 31) >> 2, ks = (lane >> 1) & 1, hh = lane & 1;
#pragma unroll
            for (int h = 0; h < 4; ++h) { const int sl = b * 4 + h;
                Xx[h] = vloadf((const float*)(ws + WS_EGX) + (size_t)sl * 3 * SEQ + 2 * SEQ + tl); rr[h] = vloadf((const float*)(ws + WS_RP) + (size_t)sl * SEQ + tl);
                qv[h] = *((const u32x4*)(ws + WS_AQM) + ((size_t)sl * NCH + n) * 2048 + w * 256 + (tb * 2 + ks) * 64 + r + 32 * hh);
                const float* np = (const float*)(ws + WS_NPREV) + ((size_t)sl * NCH + n) * 256 + 32 * w + 16 * ks + 4 * hh; na[h] = *(const f32x4*)np; nb[h] = *(const f32x4*)(np + 8); }
        }
        u32x4 ovn[4], gvn[4];
        { const int tn = task + NGW; const bool has = tn < t1; post_fetch(F, has ? tn : task, has ? it + 1 : it, ovn, gvn); }
        if (ml) {
#pragma unroll
            for (int h = 0; h < 4; ++h) {
                float part = bflo(qv[h].x) * na[h][0] + bfhi(qv[h].x) * na[h][1] + bflo(qv[h].y) * na[h][2] + bfhi(qv[h].y) * na[h][3] + bflo(qv[h].z) * nb[h][0] + bfhi(qv[h].z) * nb[h][1] + bflo(qv[h].w) * nb[h][2] + bfhi(qv[h].w) * nb[h][3];
                if (lane >= 32) part = 0.f;
                const float den = rr[h] + wave_sum(part); inv[h] = 1.f / fmaxf(fabsf(den), Xx[h]); }
        }
#pragma unroll
        for (int h = 0; h < 4; ++h) {
            float o[8] = {bflo(ov[h].x), bfhi(ov[h].x), bflo(ov[h].y), bfhi(ov[h].y), bflo(ov[h].z), bfhi(ov[h].z), bflo(ov[h].w), bfhi(ov[h].w)};
            const float gt[8] = {bflo(gv[h].x), bfhi(gv[h].x), bflo(gv[h].y), bfhi(gv[h].y), bflo(gv[h].z), bfhi(gv[h].z), bflo(gv[h].w), bfhi(gv[h].w)};
            const float nw[8] = {n0[h][0], n0[h][1], n0[h][2], n0[h][3], n1[h][0], n1[h][1], n1[h][2], n1[h][3]};
            float ss = 0.f;
#pragma unroll
            for (int j = 0; j < 8; ++j) { o[j] *= inv[h]; ss += o[j] * o[j]; }
            const float rn = __builtin_amdgcn_rsqf(wave_sum(ss) * (1.f / 512.f) + EPS);
            float y[8];
#pragma unroll
            for (int j = 0; j < 8; ++j) y[j] = o[j] * rn * nw[j] * (ml ? sigmoidf_(gt[j]) : siluf_(gt[j]));
            u32x4 wv; wv.x = cvt_pk_bf16(y[0], y[1]); wv.y = cvt_pk_bf16(y[2], y[3]); wv.z = cvt_pk_bf16(y[4], y[5]); wv.w = cvt_pk_bf16(y[6], y[7]);
            *(u32x4*)(mixed + (size_t)row * D + ml * 2048 + h * 512 + 8 * lane) = wv; }
#pragma unroll
        for (int h = 0; h < 4; ++h) { ov[h] = ovn[h]; gv[h] = gvn[h]; }
    }
}

DI void final_norm(const Frame& F, const Args& a) {
    const int gw = F.vcu * NWAVES + F.wave, NGW = F.G * NWAVES, lane = F.lane;
    const float* ss3 = (const float*)(F.ws + WS_SS3); const float* g = a.in[IN_NFING]; const bf16_t* hb = (const bf16_t*)(F.ws + WS_HB);
    u32x4 cur[8], nxt[8]; float css, nss = 0.f;
    { const u32x4* p = (const u32x4*)(hb + (size_t)gw * D) + lane;
#pragma unroll
      for (int j = 0; j < 8; ++j) cur[j] = __builtin_nontemporal_load(p + 64 * j);
      css = ss3[(size_t)gw * 64 + lane]; }
    for (int row = gw; row < M; row += NGW) {
        const int nrow = row + NGW; const bool more = nrow < M;
        if (more) { const u32x4* p = (const u32x4*)(hb + (size_t)nrow * D) + lane;
#pragma unroll
            for (int j = 0; j < 8; ++j) nxt[j] = __builtin_nontemporal_load(p + 64 * j);
            nss = ss3[(size_t)nrow * 64 + lane]; }
        const float rstd = __builtin_amdgcn_rsqf(wave_sum(css) * (1.f / D) + EPS);
        float* q = a.out + (size_t)row * D + 8 * lane;
#pragma unroll
        for (int j = 0; j < 8; ++j) { const f32x4 g0 = *(const f32x4*)(g + 512 * j + 8 * lane), g1 = *(const f32x4*)(g + 512 * j + 8 * lane + 4); const u32x4 w = cur[j];
            *(f32x4*)(q + 512 * j) = (f32x4){bflo(w.x), bfhi(w.x), bflo(w.y), bfhi(w.y)} * rstd * g0; *(f32x4*)(q + 512 * j + 4) = (f32x4){bflo(w.z), bfhi(w.z), bflo(w.w), bfhi(w.w)} * rstd * g1; }
#pragma unroll
        for (int j = 0; j < 8; ++j) cur[j] = nxt[j];
        css = nss;
    }
}

struct SchedStd {
    int nM, nN, G, c, lda, ldb; size_t a0, b0, bbatch;
    DI bool next(int i, pg8::Unit& u) const { int pm, pn; if (!pg8::static_tile(i, G, c, nM, nN, pm, pn)) return false;
        u.pm = pm; u.pn = pn; u.z = 0; u.ldc = 0; u.coff = 0; u.aoff = a0 + (size_t)pm * 256 * lda; u.boff = b0 + (size_t)(pm >> 5) * bbatch + (size_t)pn * 256 * ldb; return true; }
};
struct SchedG1 : SchedStd {
    DI bool next(int i, pg8::Unit& u) const { if (!SchedStd::next(i, u)) return false; u.ldc = NPROJ; u.coff = WS_PROJ / 2 + (size_t)u.pm * 256 * NPROJ + (size_t)u.pn * 256; return true; }
};
struct SchedRowMajor {
    int G, c; size_t a0, b0;
    DI bool next(int i, pg8::Unit& u) const { if (i >= 4 || G != 256) return false; const int x = c & 7, j = c >> 3, pm = 16 * i + 2 * x + (j >> 4), pn = j & 15;
        u.pm = pm; u.pn = pn; u.z = 0; u.ldc = 0; u.coff = 0; u.aoff = a0 + (size_t)pm * 256 * FF; u.boff = b0 + (size_t)pn * 256 * FF; return true; }
};
struct SchedKV {
    int G, c;
    DI bool next(int i, pg8::Unit& u) const { const int L = i * G + c; if (L >= 64) return false; const int which = L >> 5, pm = (L >> 4) & 1, pn = L & 15;
        u.pm = pm; u.pn = pn; u.z = which; u.ldc = D; u.aoff = WS_MEMN / 2 + (size_t)pm * 256 * D; u.boff = (which ? WS_WV : WS_WK) / 2 + (size_t)pn * 256 * D;
        u.coff = (which ? WS_VB : WS_KB) / 2 + (size_t)pm * 256 * D + (size_t)pn * 256; return true; }
};
struct SchedX {
    int G, c;
    DI bool next(int i, pg8::Unit& u) const { const int L = i * G + c; if (L >= 256) return false; const int Lq = L & 127, b = Lq >> 6, h = (Lq >> 4) & 3, p = Lq & 15;
        u.z = L >> 7;
        if (L < 128) { u.pm = 0; u.pn = p; u.ldc = D; u.aoff = WS_KB / 2 + (size_t)b * 256 * D + h * 1024; u.boff = WS_WQ / 2 + (size_t)p * 256 * D + h * 1024;
            u.coff = WS_WQK / 2 + ((size_t)b * 1024 + h * 256) * D + (size_t)p * 256; }
        else { u.pm = 0; u.pn = 0; u.ldc = 1024; u.aoff = WS_WO / 2 + (size_t)p * 256 * D + h * 1024; u.boff = WS_VB / 2 + (size_t)b * 256 * D + h * 1024;
            u.coff = WS_VW / 2 + ((size_t)b * D + (size_t)p * 256) * 1024 + h * 256; }
        return true; }
};
struct SchedScore {
    int vcu;
    DI bool next(int i, pg8::Unit& u) const { if (i > 0 || vcu >= 256) return false; const int pm = vcu >> 2, hd = vcu & 3;
        u.pm = pm; u.pn = hd; u.z = 0; u.ldc = 1024; u.coff = 0; u.aoff = WS_HB / 2 + (size_t)pm * 256 * D; u.boff = WS_WQK / 2 + ((size_t)(pm >> 5) * 1024 + hd * 256) * D; return true; }
};

__global__ void __launch_bounds__(NWAVES * 64, 2) fwd_kernel(Args args) {
    extern __shared__ __attribute__((aligned(16))) unsigned char lds_raw[];
    Frame F;
    F.lds = (LAS unsigned char*)lds_raw; F.ws = args.ws;
    F.tid = threadIdx.x; F.lane = F.tid & 63; F.wave = __builtin_amdgcn_readfirstlane(F.tid >> 6);
    F.G = gridDim.x; F.bx = blockIdx.x; F.vcu = (F.G % 8 == 0) ? (F.bx % 8) * (F.G / 8) + F.bx / 8 : F.bx;
    volatile LAS unsigned* MISC = (volatile LAS unsigned*)(F.lds + MISC_OFF);
    for (int u = F.tid; u < (LDS_BYTES - LDSCTL_OFF) / 4; u += NWAVES * 64) ((LAS unsigned*)(F.lds + LDSCTL_OFF))[u] = 0u;
    __syncthreads();
    gu32* ctl = (gu32*)(args.ws + WS_CTL);
    XcdBarrier bar = xcd_barrier_post((unsigned*)(ctl + CW_BAR), MISC + 8);
    const int lo = args.ph_lo, hi = args.ph_hi;
#define IN(k) (lo <= (k) && (k) < hi)
#define SEAM(k) do { if (IN(k) && IN((k) + 1)) xcd_barrier(bar); } while (0)
    const bf16_t* wsb = (const bf16_t*)args.ws;
    float* ss1 = (float*)(args.ws + WS_SS1); float* ss2 = (float*)(args.ws + WS_SS2); float* ss3 = (float*)(args.ws + WS_SS3);
#define PH0 { p0a_weights(F, args); }
#define PH1 { p0b_x(F, args); }
#define PH2 { pg8::Gemm g{wsb, D, D, D}; SchedKV S{F.G, F.bx}; pg8::EpiBf16 E{(bf16_t*)args.ws, nullptr, nullptr}; \
        pg8::gemm_phase<pg8::EpiBf16, SchedKV, true>(F.lds, g, S, E); }
#define PH3 { pg8::Gemm g{wsb, D, D, D}; SchedG1 S; S.nM = 64; S.nN = 48; S.G = F.G; S.c = F.bx; S.lda = D; S.ldb = D; S.a0 = (size_t)(((const char*)args.out - (const char*)args.ws) / 2); S.b0 = WS_WIN / 2; S.bbatch = 0; \
        LAS float* rl = (LAS float*)(F.lds + LDS_X1); \
        { pg8::Unit u0; if (S.next(0, u0) && F.tid < 256) rl[F.tid] = ((const float*)(args.ws + WS_RSTD0))[u0.pm * 256 + F.tid]; __syncthreads(); } \
        pg8::EpiBf16 E{(bf16_t*)args.ws, rl, nullptr}; \
        pg8::gemm_phase<pg8::EpiBf16, SchedG1, true>(F.lds, g, S, E); \
        if (F.vcu < 8) gate_scan(F, args, F.vcu); }
#define PH4 { pg8::Gemm g{wsb, D, D, 1024}; SchedX S{F.G, F.bx}; pg8::EpiBf16 E{(bf16_t*)args.ws, nullptr, nullptr}; \
        pg8::gemm_phase<pg8::EpiBf16, SchedX, true>(F.lds, g, S, E); }
#define PH5 { u32x4 pq[4], pk[4]; if (F.vcu < 2048) pre_fetch(F, F.vcu, pq, pk); for (int it = F.vcu; it < 2048; it += F.G) { const int s = it >> 7, n = it & 127, nx = (it + F.G < 2048) ? it + F.G : it; if (s < 8) pre_item<false>(F, args, s, n, pq, pk, nx); else pre_item<true>(F, args, s, n, pq, pk, nx); } }
#define PH6 { const int xg = F.bx & 7, j = F.bx >> 3;         \
        if (j < 16) { const int s = 2 * xg + (j >> 3), slice2 = j & 7; if (s < 8) scan2_stream<false>(F, args, s, slice2); else scan2_stream<true>(F, args, s, slice2); } \
        p0a_rest(F, args); }
#define PH7 { if (F.bx < 64) { pg8::Gemm g{wsb, D, D, D}; SchedKV S{F.G, F.bx}; pg8::EpiBf16 E{(bf16_t*)args.ws, nullptr, nullptr}; \
            pg8::gemm_phase<pg8::EpiBf16, SchedKV, true>(F.lds, g, S, E); } \
        else post_pass(F, args, F.bx - 64, F.G - 64, 0, M * 2); }
#define PH8 { pg8::Gemm g{wsb, D, D, D}; SchedStd S{64, 16, F.G, F.bx, D, D, WS_MIXED / 2, WS_WOUT / 2, 0}; \
        pg8::EpiResid<true> E{args.out, (bf16_t*)(args.ws + WS_HB), ss1, nullptr}; \
        pg8::gemm_phase<pg8::EpiResid<true>, SchedStd, true>(F.lds, g, S, E); }
#define PH9 { pg8::Gemm g{wsb, D, D, D}; SchedScore S{F.vcu}; pg8::EpiSoftmax E{(bf16_t*)(args.ws + WS_P), ss1}; \
        pg8::gemm_phase<pg8::EpiSoftmax, SchedScore, false>(F.lds, g, S, E); }
#define PH10 { pg8::Gemm g{wsb, 1024, 1024, 1024}; SchedStd S{64, 16, F.G, F.bx, 1024, 1024, WS_P / 2, WS_VW / 2, (size_t)D * 1024}; \
        pg8::EpiResid<true> E{args.ws + WS_HB, (bf16_t*)(args.ws + WS_MIXED), ss2, nullptr}; \
        pg8::gemm_phase<pg8::EpiResid<true>, SchedStd, true>(F.lds, g, S, E); }
#define PH11 { pg8::Gemm g{wsb, D, D, D}; SchedStd S{64, 86, F.G, F.bx, D, D, WS_MIXED / 2, WS_WGU / 2, 0}; \
        LAS float* rl = (LAS float*)(F.lds + LDS_X1); \
        { pg8::Unit u0; if (S.next(0, u0) && F.tid < 256) { const f32x4* pp = (const f32x4*)(ss2 + (size_t)(u0.pm * 256 + F.tid) * 64); float sq = 0.f; \
            _Pragma("unroll") for (int j = 0; j < 16; ++j) { const f32x4 t4 = pp[j]; sq += (t4[0] + t4[1]) + (t4[2] + t4[3]); } \
            rl[F.tid] = __builtin_amdgcn_rsqf(sq * (1.0f / D) + EPS); } __syncthreads(); } \
        pg8::EpiSwiglu E{(bf16_t*)(args.ws + WS_ACT), rl}; \
        pg8::gemm_phase<pg8::EpiSwiglu, SchedStd, true>(F.lds, g, S, E); }
#define PH12 { pg8::Gemm g{wsb, FF, FF, FF}; SchedRowMajor S{F.G, F.bx, WS_ACT / 2, WS_WDN / 2}; \
        pg8::EpiResid<true> E{args.ws + WS_MIXED, (bf16_t*)(args.ws + WS_HB), ss3, nullptr}; \
        pg8::gemm_phase<pg8::EpiResid<true>, SchedRowMajor, true>(F.lds, g, S, E); }
#define PH13 { final_norm(F, args); }
#ifndef REP_PHASE
#define REP_PHASE -1
#endif
#ifdef PROBE_TIME
#define TSTAMP(k) do { if (F.bx == 0 && F.tid == 0) MISC[16 + (k)] = (unsigned)__builtin_amdgcn_s_memrealtime(); } while (0)
#else
#define TSTAMP(k) do {} while (0)
#endif
#define RUN(k, body) TSTAMP(k); if (IN(k)) body SEAM(k);
#ifdef PROBE_SLEEP_US
#define PHSLEEP { const unsigned long long t0 = __builtin_amdgcn_s_memrealtime(); while (__builtin_amdgcn_s_memrealtime() - t0 < (unsigned long long)(PROBE_SLEEP_US) * 100ull) __builtin_amdgcn_s_sleep(32); }
#else
#define PHSLEEP {}
#endif
    RUN(0, PH0) RUN(1, PH1) RUN(2, PH3) RUN(3, PH5) RUN(4, PH6) RUN(5, PH7) RUN(6, PH4) RUN(7, PH8) RUN(8, PH9) RUN(9, PH10) RUN(10, PH11) RUN(11, PH12)
    TSTAMP(12);
    if (IN(12)) PH13
#ifdef PROBE_TIME
    TSTAMP(13);
    if (F.bx == 0 && F.tid == 0) { asm volatile("s_waitcnt vmcnt(0)" ::: "memory"); args.out[0] += (float)(MISC[16 + PROBE_TIME + 1] - MISC[16 + PROBE_TIME]) * 0.01f * PROBE_SCALE; }
#endif
#ifdef PROBE_STREAM
    if (IN(14)) {
        const int gw = F.vcu * NWAVES + F.wave, NGW = F.G * NWAVES; float* dead = (float*)(args.ws + WS_P);
        for (int row = gw; row < M; row += NGW) { const f32x4* p = (const f32x4*)(args.in[IN_X] + (size_t)row * D) + F.lane; f32x4 acc = {0.f, 0.f, 0.f, 0.f};
#pragma unroll
            for (int j = 0; j < 16; ++j) acc = acc + p[64 * j];
            const float t = wave_sum(acc[0] + acc[1] + acc[2] + acc[3]); if (F.lane == 0) dead[row] = t; }
    }
    if (IN(15)) {
        const int gw = F.vcu * NWAVES + F.wave, NGW = F.G * NWAVES; float* dead = (float*)(args.ws + WS_PROJ);
        for (int row = gw; row < M; row += NGW) { const f32x4* p = (const f32x4*)(args.in[IN_X] + (size_t)row * D) + F.lane; f32x4* q = (f32x4*)(dead + (size_t)row * D) + F.lane; f32x4 v[16];
#pragma unroll
            for (int j = 0; j < 16; ++j) v[j] = p[64 * j];
#pragma unroll
            for (int j = 0; j < 16; ++j) q[64 * j] = v[j]; }
    }
#endif
#undef IN
#undef SEAM
}

#ifdef DIAG_REPRO
__global__ void ck_kernel(const unsigned* buf, int rows, int words_per_row, unsigned* sig) {
    const int gw = (blockIdx.x * blockDim.x + threadIdx.x) >> 6, lane = threadIdx.x & 63, nw = (gridDim.x * blockDim.x) >> 6;
    for (int r = gw; r < rows; r += nw) { unsigned x = 0u; const unsigned* p = buf + (size_t)r * words_per_row;
        for (int i = lane; i < words_per_row; i += 64) x ^= p[i] * 2654435761u + (unsigned)i;
        for (int o = 1; o < 64; o <<= 1) x ^= __shfl_xor(x, o);
        if (lane == 0) sig[r] = x; }
}
__global__ void cmp_kernel(const unsigned* s0, const unsigned* s1, int rows, float* out) {
    if (blockIdx.x == 0 && threadIdx.x == 0) { int cnt = 0; for (int r = 0; r < rows; ++r) cnt += (s0[r] != s1[r]); out[0] += cnt ? 0.75f : 0.25f; }
}
#endif
#ifndef MK_PER_PHASE
#define MK_PER_PHASE 0
#endif
constexpr int NPHASES = 13;
extern "C" void kernel_launch(void* const* d_in, const int* in_sizes, int n_in, void* d_out, int out_size, void* d_ws, size_t ws_size, hipStream_t stream) {
    static int grid = 0;
    if (grid == 0) {
        if (n_in != 24 || in_sizes[0] != M * D || out_size != M * D || ws_size < WS_END) {
            fprintf(stderr, "kernel_launch: unexpected problem (n_in %d, in0 %d, out %d, ws %zu < %zu); nothing launched\n", n_in, n_in > 0 ? in_sizes[0] : -1, out_size, ws_size, (size_t)WS_END); grid = -1; return; }
        int dev = 0, cus = 0, per_cu = 0;
        if (hipGetDevice(&dev) != hipSuccess || hipDeviceGetAttribute(&cus, hipDeviceAttributeMultiprocessorCount, dev) != hipSuccess) { grid = -1; return; }
        if (hipFuncSetAttribute((const void*)fwd_kernel, hipFuncAttributeMaxDynamicSharedMemorySize, LDS_BYTES) != hipSuccess) { fprintf(stderr, "kernel_launch: hipFuncSetAttribute failed\n"); grid = -1; return; }
        if (hipOccupancyMaxActiveBlocksPerMultiprocessor(&per_cu, (const void*)fwd_kernel, NWAVES * 64, LDS_BYTES) != hipSuccess || per_cu < 1)
            fprintf(stderr, "kernel_launch: occupancy query reports %d workgroups per CU\n", per_cu);
        (void)hipGetLastError();
        grid = cus < 256 ? cus : 256;
        if (grid != 256) fprintf(stderr, "kernel_launch: %d CUs; this kernel is built for 256\n", cus);
    }
    if (grid < 0) return;
    if (hipMemsetAsync((char*)d_ws + WS_CTL, 0, CTL_ZERO_BYTES, stream) != hipSuccess) return;
    Args a{};
    for (int i = 0; i < 24; ++i) a.in[i] = (const float*)d_in[i];
    a.out = (float*)d_out; a.ws = (unsigned char*)d_ws;
#if MK_PER_PHASE
    for (int p = 0; p < NPHASES; ++p) { a.ph_lo = p; a.ph_hi = p + 1; hipLaunchKernelGGL(fwd_kernel, dim3(grid), dim3(NWAVES * 64), LDS_BYTES, stream, a); }
#else
    a.ph_lo = 0; a.ph_hi = NPHASES;
    hipLaunchKernelGGL(fwd_kernel, dim3(grid), dim3(NWAVES * 64), LDS_BYTES, stream, a);
#endif
#ifdef DIAG_REPRO
    { unsigned* sig0 = (unsigned*)((char*)d_ws + 1220 * MiB); unsigned* sig1 = sig0 + 65536;
      hipLaunchKernelGGL(ck_kernel, dim3(256), dim3(256), 0, stream, (const unsigned*)d_out, M, D, sig0);
      (void)hipMemsetAsync((char*)d_ws + WS_CTL, 0, CTL_ZERO_BYTES, stream);
      hipLaunchKernelGGL(fwd_kernel, dim3(grid), dim3(NWAVES * 64), LDS_BYTES, stream, a);
      hipLaunchKernelGGL(ck_kernel, dim3(256), dim3(256), 0, stream, (const unsigned*)d_out, M, D, sig1);
      hipLaunchKernelGGL(cmp_kernel, dim3(1), dim3(64), 0, stream, (const unsigned*)sig0, (const unsigned*)sig1, M, (float*)d_out); }
#endif
#ifdef PROBE_EXTRA
    { const int extra[] = PROBE_EXTRA; for (int p : extra) { a.ph_lo = p; a.ph_hi = p + 1; hipLaunchKernelGGL(fwd_kernel, dim3(grid), dim3(NWAVES * 64), LDS_BYTES, stream, a); } }
#endif
    const hipError_t le = hipPeekAtLastError();
    if (le != hipSuccess) fprintf(stderr, "kernel_launch: launch failed: %s\n", hipGetErrorName(le));
}
```
